# Optimizing an MI355X kernel written in HIP

```python
import math
import jax, jax.numpy as jnp
from jax import lax
import numpy as np

D_MODEL = 2048
BATCH = 16
SEQ = 2048
DEPTH = 4

GRID_W = 64
CTX_LEN = 256

A_HEADS = 8
A_HD = 64
A_W = A_HEADS * A_HD
A_DECAY_R = 32
A_ICLR_R = 32
A_GATE_R = 96
W_DECAY_SCALE = math.exp(-0.5)
RWKV_GN_EPS = 64e-5

B_HEADS = 8
B_NOPE = 128
B_ROPE = 64
B_VD = 128
B_QR = 512
B_KVR = 256
B_W = B_HEADS * B_VD

C_HEADS = 4
C_KD = 64
C_VD = 128
C_W = C_HEADS * C_VD
CHUNK = 128
RET_GN_EPS = 1e-5

MIX_W = A_W + B_W + C_W

A_COLS = 3 * A_W + 2 * A_DECAY_R + 2 * A_ICLR_R + A_GATE_R
B_COLS = B_QR + B_KVR + B_ROPE
C_COLS = 2 * C_HEADS * C_KD + C_W + C_W
IN_COLS = A_COLS + B_COLS + C_COLS
IN_SPLITS = (A_COLS, A_COLS + B_COLS)
A_SPLITS = (A_W, 2 * A_W, 3 * A_W, 3 * A_W + 2 * A_DECAY_R, 3 * A_W + 2 * A_DECAY_R + 2 * A_ICLR_R)
B_SPLITS = (B_QR, B_QR + B_KVR)
C_SPLITS = (C_HEADS * C_KD, 2 * C_HEADS * C_KD, 2 * C_HEADS * C_KD + C_W)

N_EXPERTS = 16
N_GROUPS = 4
EXPERTS_PER_GROUP = N_EXPERTS // N_GROUPS
TOP_K = 2
D_EXPERT = 512
ROUTE_SCALE = 2.5

ALPHA = (2 * DEPTH) ** 0.25
BETA = (8 * DEPTH) ** -0.25
ROPE_BASE = 10000.0
QBLOCK = 128
LN_EPS = 1e-5

kernel_name = 'hybrid_rwkv7_mla_retention_moe_dit'


def layer_norm(x, g, b, eps=LN_EPS):
    xf = x.astype(jnp.float32)
    xc = xf - jnp.mean(xf, -1, keepdims=True)
    var = jnp.mean(xc * xc, -1, keepdims=True)
    return (xc * lax.rsqrt(var + eps) * g + b).astype(x.dtype)


def rms_norm(x, g, eps=LN_EPS):
    xf = x.astype(jnp.float32)
    return (xf * lax.rsqrt(jnp.mean(xf * xf, -1, keepdims=True) + eps) * g).astype(x.dtype)


def centred_shift(x):
    xp = jnp.pad(x, ((0, 0), (1, 1), (0, 0)))
    return 0.5 * (xp[:, :-2] + xp[:, 2:])


def grid_rope_tables(rows, dim):
    n = dim // 4
    inv = ROPE_BASE ** (-jnp.arange(n, dtype=jnp.float32) / n)
    r = jnp.repeat(jnp.arange(rows, dtype=jnp.float32), GRID_W)
    col = jnp.tile(jnp.arange(GRID_W, dtype=jnp.float32), rows)
    ang = jnp.concatenate([r[:, None] * inv, col[:, None] * inv], -1)
    return jnp.cos(ang), jnp.sin(ang)


def apply_rope(x, cos, sin):
    x1, x2 = jnp.split(x, 2, axis=-1)
    return jnp.concatenate([x1 * cos - x2 * sin, x1 * sin + x2 * cos], -1).astype(x.dtype)


def rwkv7_scan(r, w, k, v, kk, a, state0):
    def step(S, inp):
        r_t, w_t, k_t, v_t, kk_t, a_t = inp
        sa = jnp.einsum('bhvk,bhk->bhv', S, -kk_t)
        S = (S * w_t[:, :, None, :] + sa[..., None] * (kk_t * a_t)[:, :, None, :]
             + v_t[..., None] * k_t[:, :, None, :])
        return S, jnp.einsum('bhvk,bhk->bhv', S, r_t)
    xs = tuple(jnp.moveaxis(t, 1, 0) for t in (r, w, k, v, kk, a))
    S, ys = lax.scan(step, state0, xs)
    return jnp.moveaxis(ys, 0, 1), S


def rwkv_feats(pa, mu, w0, w_up, a0, a_up, g_up, k_k, k_a):
    B, L, _ = pa.shape
    pa = pa + (centred_shift(pa) - pa) * mu
    r, k, v, wd, ad, gd = jnp.split(pa, A_SPLITS, axis=-1)
    wd = wd.reshape(B, L, 2, A_DECAY_R)
    ad = ad.reshape(B, L, 2, A_ICLR_R)
    w = jnp.exp(-W_DECAY_SCALE * jax.nn.sigmoid(w0 + jnp.einsum('bldr,drc->bldc', jnp.tanh(wd), w_up)))
    a = jax.nn.sigmoid(a0 + jnp.einsum('bldr,drc->bldc', ad, a_up))
    g = jax.nn.sigmoid(gd) @ g_up
    heads = lambda t: t.reshape(t.shape[:-1] + (A_HEADS, A_HD)).astype(jnp.float32)
    kk = heads(k * k_k)
    kk = kk * lax.rsqrt(jnp.sum(kk * kk, -1, keepdims=True) + 1e-12)
    kd = k[:, :, None] * (1.0 + (a - 1.0) * k_a)
    return heads(r), heads(v), kk, heads(w), heads(a), heads(kd), g


def rwkv_mixer(pa_ctx, pa_lat, mu, w0, w_up, a0, a_up, g_up, k_k, k_a, r_k, gn_g, gn_b, with_ctx):
    fc = rwkv_feats(pa_ctx, mu, w0, w_up, a0, a_up, g_up, k_k, k_a)
    fl = rwkv_feats(pa_lat, mu, w0, w_up, a0, a_up, g_up, k_k, k_a)
    zero = jnp.zeros((pa_lat.shape[0], A_HEADS, A_HD, A_HD), jnp.float32)
    flip = lambda t: jnp.flip(t, 1)

    def bi_scan(f, s0_fwd, s0_bwd):
        r, v, kk, w, a, kd, _ = f
        yf, sf = rwkv7_scan(r, w[:, :, 0], kd[:, :, 0], v, kk, a[:, :, 0], s0_fwd)
        yb, sb = rwkv7_scan(flip(r), flip(w[:, :, 1]), flip(kd[:, :, 1]), flip(v), flip(kk),
                            flip(a[:, :, 1]), s0_bwd)
        return yf + flip(yb), sf, sb

    def finish(f, y, dtype):
        r, v, kk, w, a, kd, g = f
        bonus = jnp.sum(jnp.sum(r[:, :, None] * kd * r_k, -1, keepdims=True), 2) * v
        o = layer_norm(y, gn_g.reshape(A_HEADS, A_HD), gn_b.reshape(A_HEADS, A_HD), RWKV_GN_EPS) + bonus
        return (o.reshape(o.shape[0], o.shape[1], A_W) * g).astype(dtype)

    yc, sfc, sbc = bi_scan(fc, zero, zero)
    yl, _, _ = bi_scan(fl, sfc, sbc)
    out_ctx = finish(fc, yc, pa_ctx.dtype) if with_ctx else None
    return out_ctx, finish(fl, yl, pa_lat.dtype)


def mla_qkv(pb, q_norm, kv_norm, w_uq, w_ukv, rope):
    B, L, _ = pb.shape
    cq, ckv, kr = jnp.split(pb, B_SPLITS, axis=-1)
    q = jnp.swapaxes((rms_norm(cq, q_norm) @ w_uq).reshape(B, L, B_HEADS, B_NOPE + B_ROPE), 1, 2)
    kv = jnp.swapaxes((rms_norm(ckv, kv_norm) @ w_ukv).reshape(B, L, B_HEADS, B_NOPE + B_VD), 1, 2)
    q_nope, q_rope = q[..., :B_NOPE], q[..., B_NOPE:]
    k_nope, v = kv[..., :B_NOPE], kv[..., B_NOPE:]
    kr = kr[:, None]
    if rope is not None:
        cos, sin = rope
        q_rope = apply_rope(q_rope, cos, sin)
        kr = apply_rope(kr, cos, sin)
    q = jnp.concatenate([q_nope, q_rope], -1)
    k = jnp.concatenate([k_nope, jnp.broadcast_to(kr, (B, B_HEADS, L, B_ROPE))], -1)
    return q, k, v


def block_attention(q, k, v):
    B, H, L, dq = q.shape
    nb = L // QBLOCK
    qb = jnp.moveaxis(q.reshape(B, H, nb, QBLOCK, dq), 2, 0)
    scale = dq ** -0.5

    def one(qi):
        s = jnp.einsum('bhqd,bhkd->bhqk', qi, k).astype(jnp.float32) * scale
        p = jax.nn.softmax(s, axis=-1).astype(v.dtype)
        return jnp.einsum('bhqk,bhkd->bhqd', p, v)
    o = lax.map(one, qb)
    return jnp.moveaxis(o, 0, 2).reshape(B, H, L, v.shape[-1])


def mla_mixer(pb_ctx, pb_lat, q_norm, kv_norm, w_uq, w_ukv, rope, with_ctx):
    qc, kc, vc = mla_qkv(pb_ctx, q_norm, kv_norm, w_uq, w_ukv, None)
    ql, kl, vl = mla_qkv(pb_lat, q_norm, kv_norm, w_uq, w_ukv, rope)
    merge = lambda o: jnp.swapaxes(o, 1, 2).reshape(o.shape[0], o.shape[2], B_W)
    o_lat = block_attention(ql, jnp.concatenate([kc, kl], 2), jnp.concatenate([vc, vl], 2))
    o_ctx = merge(block_attention(qc, kc, vc)) if with_ctx else None
    return o_ctx, merge(o_lat)


def retention_gammas():
    h = jnp.arange(C_HEADS, dtype=jnp.float32)
    return jnp.stack([1.0 - 2.0 ** (-5.0 - h), 1.0 - 2.0 ** (-5.5 - h)])


def retention_chunks(q, k, v, gamma, state0):
    B, H, L, dk = q.shape
    dv = v.shape[-1]
    nc = L // CHUNK
    lg = jnp.log(gamma)
    pos = jnp.arange(CHUNK, dtype=jnp.float32)
    diff = pos[:, None] - pos[None, :]
    intra = jnp.where(diff >= 0, jnp.exp(lg[:, None, None] * jnp.maximum(diff, 0.0)), 0.0)
    q_decay = jnp.exp(lg[:, None] * (pos + 1.0))[:, :, None]
    k_decay = jnp.exp(lg[:, None] * (CHUNK - 1.0 - pos))[:, :, None]
    chunk_decay = jnp.exp(lg * CHUNK)[:, None, None]
    split = lambda t: jnp.moveaxis(t.reshape(B, H, nc, CHUNK, t.shape[-1]), 2, 0)

    def step(R, inp):
        qc, kc, vc = inp
        att = jnp.einsum('bhqd,bhkd->bhqk', qc, kc) * intra
        o = jnp.einsum('bhqk,bhkv->bhqv', att, vc) + jnp.einsum('bhqd,bhdv->bhqv', qc, R) * q_decay
        R = R * chunk_decay + jnp.einsum('bhkd,bhkv->bhdv', kc * k_decay, vc)
        return R, o
    R, o = lax.scan(step, state0, (split(q), split(k), split(v)))
    return jnp.moveaxis(o, 0, 2).reshape(B, H, L, dv), R


def ret_qkvg(pc, rope):
    B, L, _ = pc.shape
    q, k, v, gt = jnp.split(pc, C_SPLITS, axis=-1)
    hs = lambda t, d: jnp.swapaxes(t.reshape(B, L, C_HEADS, d), 1, 2)
    q, k, v = hs(q, C_KD), hs(k, C_KD) * C_KD ** -0.5, hs(v, C_VD)
    if rope is not None:
        cos, sin = rope
        q = apply_rope(q, cos, sin)
        k = apply_rope(k, cos, sin)
    return q.astype(jnp.float32), k.astype(jnp.float32), v.astype(jnp.float32), gt


def retention_mixer(pc_ctx, pc_lat, gn_g, gn_b, rope, with_ctx):
    qc, kc, vc, gc = ret_qkvg(pc_ctx, None)
    ql, kl, vl, gl = ret_qkvg(pc_lat, rope)
    gam = retention_gammas()
    zero = jnp.zeros((pc_lat.shape[0], C_HEADS, C_KD, C_VD), jnp.float32)
    flip = lambda t: jnp.flip(t, 2)

    def bi(q, k, v, s0f, s0b):
        of, sf = retention_chunks(q, k, v, gam[0], s0f)
        ob, sb = retention_chunks(flip(q), flip(k), flip(v), gam[1], s0b)
        return of + flip(ob), sf, sb

    def finish(o, gt):
        o = layer_norm(jnp.swapaxes(o, 1, 2), gn_g.reshape(C_HEADS, C_VD), gn_b.reshape(C_HEADS, C_VD),
                       RET_GN_EPS)
        return (o.reshape(o.shape[0], o.shape[1], C_W) * jax.nn.silu(gt)).astype(gt.dtype)

    oc, sfc, sbc = bi(qc, kc, vc, zero, zero)
    ol, _, _ = bi(ql, kl, vl, sfc, sbc)
    out_ctx = finish(oc, gc) if with_ctx else None
    return out_ctx, finish(ol, gl)


def moe(u, router_w, router_b, w1, w3, w2):
    s = jax.nn.sigmoid((u @ router_w).astype(jnp.float32))
    sb = s + router_b
    grouped = sb.reshape(sb.shape[:-1] + (N_GROUPS, EXPERTS_PER_GROUP))
    group_score = jnp.sum(lax.top_k(grouped, 2)[0], -1)
    best = jnp.argmax(group_score, -1)
    in_group = jnp.repeat(best[..., None] == jnp.arange(N_GROUPS), EXPERTS_PER_GROUP, axis=-1)
    _, idx = lax.top_k(jnp.where(in_group, sb, -jnp.inf), TOP_K)
    sel = jnp.take_along_axis(s, idx, -1)
    wts = sel / jnp.sum(sel, -1, keepdims=True) * ROUTE_SCALE
    gates = jnp.sum(jax.nn.one_hot(idx, N_EXPERTS, dtype=jnp.float32) * wts[..., None], -2).astype(u.dtype)
    out = jnp.zeros_like(u)
    for e in range(N_EXPERTS):
        hdn = jax.nn.silu(u @ w1[e]) * (u @ w3[e])
        out = out + gates[..., e:e + 1] * (hdn @ w2[e])
    return out


def setup_inputs(seed: int = 0) -> dict:
    key = jax.random.key(seed)
    ks = iter(jax.random.split(key, 40))
    nrm = lambda shape, s: jax.random.normal(next(ks), shape, jnp.float32) * s
    D = D_MODEL
    chan = jnp.arange(A_W, dtype=jnp.float32) / (A_W - 1)
    decay_speed = -6.5 + 5.0 * chan ** 0.85
    return {
        'x': nrm((BATCH, SEQ, D), 1.0),
        'c': nrm((BATCH, D), 1.0),
        'ctx': nrm((BATCH, CTX_LEN, D), 1.0),
        'c_ctx': nrm((D,), 1.0),
        'mod_w': nrm((DEPTH, D, 6 * D), 0.5 * D ** -0.5),
        'mod_b': nrm((DEPTH, 6 * D), 0.02),
        'w_in': nrm((DEPTH, D, IN_COLS), D ** -0.5),
        'w_out': nrm((DEPTH, MIX_W, D), BETA * MIX_W ** -0.5),
        'rw_mu': jax.random.uniform(next(ks), (DEPTH, A_COLS), jnp.float32),
        'rw_w0': decay_speed + nrm((DEPTH, 2, A_W), 0.1),
        'rw_w_up': nrm((DEPTH, 2, A_DECAY_R, A_W), 0.1 * A_DECAY_R ** -0.5),
        'rw_a0': nrm((DEPTH, 2, A_W), 0.3),
        'rw_a_up': nrm((DEPTH, 2, A_ICLR_R, A_W), 0.3 * A_ICLR_R ** -0.5),
        'rw_g_up': nrm((DEPTH, A_GATE_R, A_W), A_GATE_R ** -0.5),
        'rw_k_k': 0.85 + nrm((DEPTH, A_W), 0.05),
        'rw_k_a': 1.0 + nrm((DEPTH, A_W), 0.05),
        'rw_r_k': nrm((DEPTH, A_HEADS, A_HD), 0.1),
        'rw_gn_g': 1.0 + nrm((DEPTH, A_W), 0.05),
        'rw_gn_b': nrm((DEPTH, A_W), 0.02),
        'mla_q_norm': 1.0 + nrm((DEPTH, B_QR), 0.05),
        'mla_kv_norm': 1.0 + nrm((DEPTH, B_KVR), 0.05),
        'mla_w_uq': nrm((DEPTH, B_QR, B_HEADS * (B_NOPE + B_ROPE)), B_QR ** -0.5),
        'mla_w_ukv': nrm((DEPTH, B_KVR, B_HEADS * (B_NOPE + B_VD)), B_KVR ** -0.5),
        'ret_gn_g': 1.0 + nrm((DEPTH, C_W), 0.05),
        'ret_gn_b': nrm((DEPTH, C_W), 0.02),
        'ln1_g': 1.0 + nrm((DEPTH, D), 0.05),
        'ln1_b': nrm((DEPTH, D), 0.02),
        'ln2_g': 1.0 + nrm((DEPTH, D), 0.05),
        'ln2_b': nrm((DEPTH, D), 0.02),
        'router_w': nrm((D, N_EXPERTS), D ** -0.5),
        'router_b': nrm((N_EXPERTS,), 0.01),
        'exp_w1': nrm((DEPTH, N_EXPERTS, D, D_EXPERT), D ** -0.5),
        'exp_w3': nrm((DEPTH, N_EXPERTS, D, D_EXPERT), D ** -0.5),
        'exp_w2': nrm((DEPTH, N_EXPERTS, D_EXPERT, D), BETA * D_EXPERT ** -0.5),
    }


def reference(x, c, ctx, c_ctx, mod_w, mod_b, w_in, w_out, rw_mu, rw_w0, rw_w_up, rw_a0, rw_a_up,
              rw_g_up, rw_k_k, rw_k_a, rw_r_k, rw_gn_g, rw_gn_b, mla_q_norm, mla_kv_norm, mla_w_uq,
              mla_w_ukv, ret_gn_g, ret_gn_b, ln1_g, ln1_b, ln2_g, ln2_b, router_w, router_b,
              exp_w1, exp_w3, exp_w2):
    rows = x.shape[1] // GRID_W
    rope_b = grid_rope_tables(rows, B_ROPE)
    rope_c = grid_rope_tables(rows, C_KD)
    silu_c = jax.nn.silu(c)
    silu_cc = jax.nn.silu(c_ctx)
    h = ctx
    for l in range(DEPTH):
        with_ctx = l < DEPTH - 1
        sh1, sc1, g1, sh2, sc2, g2 = jnp.split((silu_c @ mod_w[l] + mod_b[l])[:, None, :], 6, axis=-1)
        csh1, csc1, cg1, csh2, csc2, cg2 = jnp.split(silu_cc @ mod_w[l] + mod_b[l], 6, axis=-1)
        pa_l, pb_l, pc_l = jnp.split((x * (1.0 + sc1) + sh1) @ w_in[l], IN_SPLITS, axis=-1)
        pa_c, pb_c, pc_c = jnp.split((h * (1.0 + csc1) + csh1) @ w_in[l], IN_SPLITS, axis=-1)
        a_c, a_l = rwkv_mixer(pa_c, pa_l, rw_mu[l], rw_w0[l], rw_w_up[l], rw_a0[l], rw_a_up[l], rw_g_up[l],
                              rw_k_k[l], rw_k_a[l], rw_r_k[l], rw_gn_g[l], rw_gn_b[l], with_ctx)
        b_c, b_l = mla_mixer(pb_c, pb_l, mla_q_norm[l], mla_kv_norm[l], mla_w_uq[l], mla_w_ukv[l],
                             rope_b, with_ctx)
        r_c, r_l = retention_mixer(pc_c, pc_l, ret_gn_g[l], ret_gn_b[l], rope_c, with_ctx)
        mix_l = jnp.concatenate([a_l, b_l, r_l], axis=-1) @ w_out[l]
        if with_ctx:
            mix_c = jnp.concatenate([a_c, b_c, r_c], axis=-1) @ w_out[l]
            h = layer_norm(ALPHA * h + cg1 * mix_c, ln1_g[l], ln1_b[l])
            ffn_c = moe(h * (1.0 + csc2) + csh2, router_w, router_b, exp_w1[l], exp_w3[l], exp_w2[l])
            h = layer_norm(ALPHA * h + cg2 * ffn_c, ln2_g[l], ln2_b[l])
        x = layer_norm(ALPHA * x + g1 * mix_l, ln1_g[l], ln1_b[l])
        ffn_l = moe(x * (1.0 + sc2) + sh2, router_w, router_b, exp_w1[l], exp_w3[l], exp_w2[l])
        x = layer_norm(ALPHA * x + g2 * ffn_l, ln2_g[l], ln2_b[l])
    return x
```

```cpp
#include <hip/hip_runtime.h>
#include <cstdio>
#include <cstdint>
#include <cstring>

#define LAS __attribute__((address_space(3)))
#ifndef DBG_MASK
#define DBG_MASK 0
#endif
typedef unsigned short bf16_t;
typedef short bf16x8 __attribute__((ext_vector_type(8)));
typedef short s16x4 __attribute__((ext_vector_type(4)));
typedef float f32x2 __attribute__((ext_vector_type(2)));
typedef float f32x4 __attribute__((ext_vector_type(4)));
typedef float f32x8 __attribute__((ext_vector_type(8)));
typedef float f32x16 __attribute__((ext_vector_type(16)));
typedef unsigned u32x2 __attribute__((ext_vector_type(2)));
typedef unsigned u32x4 __attribute__((ext_vector_type(4)));

constexpr int NB = 16, LC = 256, LL = 2048, LT = LC + LL, MT = NB * LT;
constexpr int DM = 2048, DEPTH = 4;
constexpr int NPC = 4352;
constexpr int IN_COLS = 4128;
constexpr int NEXP = 16, DEXP = 512;
constexpr float ALPHA_F = 1.681792830507429f;
constexpr float LN_EPS_F = 1e-5f;
constexpr int PC_R = 0, PC_K = 512, PC_V = 1024, PC_CQ = 1536, PC_CKV = 2048, PC_RQ = 2304, PC_RK = 2560, PC_RV = 2816, PC_RG = 3328,
              PC_WD = 3840, PC_AD = 3904, PC_GD = 3968, PC_KR = 4064;
constexpr int OPS_HW = 704, OPS_W = 8 * OPS_HW;
constexpr int MAXTILES = 304;

constexpr size_t al256(size_t x) { return (x + 255) / 256 * 256; }
constexpr size_t WS_CTL = 0, CTL_BYTES = 65536;
constexpr size_t WS_MOD = WS_CTL + CTL_BYTES;
constexpr size_t WS_COS = WS_MOD + al256((size_t)DEPTH * 17 * 12288 * 4);
constexpr size_t WS_SIN = WS_COS + (size_t)2048 * 32 * 4;
constexpr size_t WS_WIN = WS_SIN + (size_t)2048 * 32 * 4;
constexpr size_t WS_WOUT = WS_WIN + (size_t)NPC * DM * 2;
constexpr size_t WS_WUQ = WS_WOUT + (size_t)DM * DM * 2;
constexpr size_t WS_WUKV = WS_WUQ + (size_t)1536 * 512 * 2;
constexpr size_t WS_W13 = WS_WUKV + (size_t)2048 * 256 * 2;
constexpr size_t WS_W2 = WS_W13 + (size_t)NEXP * 1024 * DM * 2;
constexpr size_t WS_WUP = WS_W2 + (size_t)NEXP * DM * DEXP * 2;
constexpr size_t WS_AUP = WS_WUP + (size_t)2 * 512 * 32 * 2;
constexpr size_t WS_GUP = WS_AUP + (size_t)2 * 512 * 32 * 2;
constexpr size_t WS_XC = al256(WS_GUP + (size_t)512 * 96 * 2);
constexpr size_t WS_ACT = WS_XC;
constexpr size_t WS_P = WS_ACT + (size_t)MT * DM * 2;
constexpr size_t WS_OPS = WS_P + (size_t)MT * NPC * 2;
constexpr size_t WS_Q = WS_OPS + (size_t)MT * OPS_W * 2;
constexpr size_t WS_KV = WS_Q + (size_t)MT * 1536 * 2;
constexpr size_t WS_KR = WS_KV + (size_t)MT * 2048 * 2;
constexpr size_t WS_RQ = WS_KR + (size_t)MT * 64 * 2;
constexpr size_t WS_RK = WS_RQ + (size_t)MT * 256 * 2;
constexpr size_t WS_YF = WS_RK + (size_t)MT * 256 * 2;
constexpr size_t WS_YB = WS_YF + (size_t)MT * 512 * 2;
constexpr size_t WS_OF = WS_YB + (size_t)MT * 512 * 2;
constexpr size_t WS_OB = WS_OF + (size_t)MT * 512 * 2;
constexpr size_t WS_XB = WS_OB + (size_t)MT * 512 * 2;
constexpr size_t WS_G = WS_XB + (size_t)MT * DM * 2;
constexpr size_t WS_BON = WS_G + (size_t)MT * 512 * 2;
constexpr size_t WS_RSQ = WS_BON + (size_t)MT * 8 * 4;
constexpr size_t WS_RSKV = WS_RSQ + (size_t)MT * 4;
constexpr size_t WS_VSH = al256(WS_RSKV + (size_t)MT * 4);
constexpr size_t WS_END = al256(WS_VSH + (size_t)MT * 512 * 2);
constexpr size_t WS_MIX = WS_ACT;
constexpr size_t WS_H = WS_OPS + (size_t)160 * 1024 * 1024;
constexpr size_t WS_MO = WS_P;
constexpr size_t WS_Y = WS_P;
constexpr size_t WS_LIST = WS_KV;
constexpr size_t WS_TINF = WS_KV + (size_t)NEXP * MT * 4;
static_assert((size_t)MT * DM * 2 <= (size_t)160 * 1024 * 1024 && WS_H + (size_t)MAXTILES * 256 * 512 * 2 <= WS_Q, "overlay H");
static_assert((size_t)MAXTILES * 256 * 2048 * 2 <= (size_t)MT * NPC * 2, "overlay Y");
static_assert(WS_TINF + (size_t)MT * 32 <= WS_KR, "overlay LIST/TINF");

constexpr int CW_BAR = 0;
constexpr int CW_DET = 3968;
constexpr int CW_CNT = 4096;

struct Params {
    const float* in[34];
    float* out;
    unsigned char* ws;
    int ph_lo, ph_hi;
};

__device__ __forceinline__ float bf2f(bf16_t b) { return __uint_as_float(((unsigned)b) << 16); }
typedef __bf16 bf16x2_t __attribute__((ext_vector_type(2)));
__device__ __forceinline__ unsigned cvt_pk_bf16(float lo, float hi) { const f32x2 v = {lo, hi}; return __builtin_bit_cast(unsigned, __builtin_convertvector(v, bf16x2_t)); }
__device__ __forceinline__ bf16_t f2bf(float f) { return __builtin_bit_cast(bf16_t, (__bf16)f); }
__device__ __forceinline__ float sigmoidf_(float x) { return __builtin_amdgcn_rcpf(1.0f + __expf(-x)); }
__device__ __forceinline__ float siluf_(float x) { return x * __builtin_amdgcn_rcpf(1.0f + __expf(-x)); }
__device__ __forceinline__ void unpack8(const bf16x8 v, float (&f)[8]) {
#pragma unroll
    for (int i = 0; i < 8; ++i) f[i] = bf2f((bf16_t)v[i]);
}
__device__ __forceinline__ bf16x8 pack8(const float (&f)[8]) {
    u32x4 w; w.x = cvt_pk_bf16(f[0], f[1]); w.y = cvt_pk_bf16(f[2], f[3]); w.z = cvt_pk_bf16(f[4], f[5]); w.w = cvt_pk_bf16(f[6], f[7]);
    return *reinterpret_cast<bf16x8*>(&w);
}
__device__ __forceinline__ int tid_() { int t = threadIdx.x; asm volatile("" : "+v"(t)); return t; }
#define XB_TMO      128
#define XB_XCNT(j)  (256  + 64 * (j))
#define XB_XSUB(j)  (1280 + 64 * (j))
#define XB_XGEN(j)  (2304 + 64 * (j))
#define XB_TOP      3328
#define XB_TOPGEN   3392
#define XCD_BAR_WORDS 3456
#define XB_SPIN_CAP (1u << 18)

__device__ __forceinline__ unsigned xb_ld(unsigned* p)              { return __hip_atomic_load(p, __ATOMIC_RELAXED, __HIP_MEMORY_SCOPE_AGENT); }
__device__ __forceinline__ unsigned xb_add(unsigned* p, unsigned v) { return __hip_atomic_fetch_add(p, v, __ATOMIC_RELAXED, __HIP_MEMORY_SCOPE_AGENT); }
__device__ __forceinline__ unsigned xb_xcc_id() { return (unsigned)__builtin_amdgcn_s_getreg((3 << 11) | 20) & 0xFu; }
#define XB_SPIN(cond, bar) do { unsigned _sp = 0; while (cond) { __builtin_amdgcn_s_sleep(1); \
    if ((++_sp & 255u) == 0u) { if (xb_ld(&(bar)[XB_TMO])) break; if (_sp > XB_SPIN_CAP) { atomicAdd(&(bar)[XB_TMO], 1u); break; } } } } while (0)

struct XcdBarrier {
    unsigned* bar; unsigned x;
    volatile LAS unsigned* st;
};

__device__ __forceinline__ XcdBarrier xcd_barrier_post(unsigned* bar, volatile LAS unsigned* st) {
    XcdBarrier b; b.bar = bar; b.x = xb_xcc_id(); b.st = st;
    if (threadIdx.x == 0) (void)xb_add(&bar[XB_XCNT(b.x)], 1u);
    return b;
}
__device__ __forceinline__ void xcd_barrier_complete(unsigned* bar, unsigned x, unsigned& nloc, unsigned& nx) {
    const unsigned G = gridDim.x * gridDim.y * gridDim.z;
    unsigned sum, cnt, mine, sp = 0u;
    for (;;) {
        sum = 0u; cnt = 0u; mine = 0u;
#pragma unroll
        for (unsigned j = 0; j < 16; ++j) { const unsigned c = xb_ld(&bar[XB_XCNT(j)]); sum += c; cnt += (c > 0u) ? 1u : 0u; mine = (j == x) ? c : mine; }
        if (sum == G) break;
        __builtin_amdgcn_s_sleep(1);
        if ((++sp & 255u) == 0u) { if (xb_ld(&bar[XB_TMO])) break; if (sp > XB_SPIN_CAP) { atomicAdd(&bar[XB_TMO], 1u); break; } }
    }
    nloc = mine > 0u ? mine : 1u; nx = cnt > 0u ? cnt : 1u;
}

__device__ __forceinline__ void xcd_barrier(const XcdBarrier& b) {
    asm volatile("s_waitcnt vmcnt(0)" ::: "memory");
    __syncthreads();
    if (threadIdx.x == 0) {
        unsigned* bar = b.bar;
        __builtin_amdgcn_s_waitcnt(0);
        unsigned nloc = b.st[0], nx = b.st[1];
        if (nloc == 0u) { xcd_barrier_complete(bar, b.x, nloc, nx); b.st[0] = nloc; b.st[1] = nx; }
        const unsigned old = xb_add(&bar[XB_XSUB(b.x)], 1u);
        const unsigned gen = old / nloc;
        if (old + 1u == (gen + 1u) * nloc) {
            __builtin_amdgcn_fence(__ATOMIC_RELEASE, "agent");
            asm volatile("s_waitcnt vmcnt(0)" ::: "memory");
            const unsigned og = xb_add(&bar[XB_TOP], 1u);
            const unsigned tg = og / nx;
            if (og + 1u == (tg + 1u) * nx) xb_add(&bar[XB_TOPGEN], 1u);
            else XB_SPIN(xb_ld(&bar[XB_TOPGEN]) == tg, bar);
            __builtin_amdgcn_fence(__ATOMIC_ACQUIRE, "agent");
            xb_add(&bar[XB_XGEN(b.x)], 1u);
            asm volatile("s_waitcnt vmcnt(0)" ::: "memory");
        } else {
            XB_SPIN(xb_ld(&bar[XB_XGEN(b.x)]) == gen, bar);
            __builtin_amdgcn_fence(__ATOMIC_ACQUIRE, "agent");
            asm volatile("s_waitcnt vmcnt(0)" ::: "memory");
        }
    }
    __syncthreads();
}
namespace pg8 {
constexpr int BM = 256, BK = 64, HALF = 128, HTB = HALF * BK * 2  , STAGE_BYTES = 8 * HTB, NXCD = 8, WGM = 8;
__host__ __device__ __forceinline__ int lds_byte(int r, int c) { const int st = (r >> 4) * 2 + (c >> 5), rr = r & 15, cc = c & 31, ob = rr * 64 + cc * 2; return st * 1024 + (ob ^ (((ob >> 9) & 1) << 5)); }
__host__ __device__ __forceinline__ void stage_rc(int b, int& R, int& C) { const int st = b / 1024, sb = b % 1024, swz = sb ^ (((sb >> 9) & 1) << 5); R = (st >> 1) * 16 + swz / 64; C = (st & 1) * 32 + (swz % 64) / 2; }
__host__ __device__ __forceinline__ int perm32(int rho) { const int n = rho >> 4, i = rho & 15; return 8 * (i >> 2) + 4 * n + (i & 3); }

struct Unit { const char* a; const char* b; int row0, col0; const int* lst; int aux; };

__device__ __forceinline__ bool tile_order(long L, int nM, int nN, int& pm, int& pn) {
    const int nwg = nM * nN; if (L >= nwg) return false;
    int wgid = (int)L; { const int q = nwg / NXCD, r = nwg % NXCD, xcd = wgid % NXCD, off = wgid / NXCD; wgid = (xcd < r ? xcd * (q + 1) : r * (q + 1) + (xcd - r) * q) + off; }
    const int nig = WGM * nN, gid = wgid / nig, fm = gid * WGM, gsz = (nM - fm) < WGM ? (nM - fm) : WGM;
    pm = fm + ((wgid % nig) % gsz); pn = (wgid % nig) / gsz; return true;
}

template <int MODE> struct EpiBf16 {
    bf16_t* O; int ldc; const float* rs;
    __device__ __forceinline__ void operator()(const f32x4 (&acc)[2][2][4][2], const Unit& u, int wr, int wc, int fr, int fq) const {
        const int row0 = u.row0 + wr * 64 + fr;
#pragma unroll
        for (int ai = 0; ai < 2; ++ai)
#pragma unroll
            for (int m = 0; m < 4; ++m) {
                const int r = row0 + ai * HALF + m * 16;
                if (MODE == 0) {
                    const float sc = rs ? rs[r] : 1.0f;
                    bf16_t* rowp = O + (size_t)r * ldc + u.col0 + wc * 32 + 8 * fq;
#pragma unroll
                    for (int bj = 0; bj < 2; ++bj) { const f32x4 v0 = acc[ai][bj][m][0] * sc, v1 = acc[ai][bj][m][1] * sc;
                        u32x4 w; w.x = cvt_pk_bf16(v0[0], v0[1]); w.y = cvt_pk_bf16(v0[2], v0[3]); w.z = cvt_pk_bf16(v1[0], v1[1]); w.w = cvt_pk_bf16(v1[2], v1[3]);
                        *(u32x4*)(rowp + bj * HALF) = w; }
                } else {
                    bf16_t* rowp = O + (size_t)r * ldc + (u.col0 >> 1) + wc * 16 + 4 * fq;
#pragma unroll
                    for (int bj = 0; bj < 2; ++bj) { const f32x4 a = acc[ai][bj][m][0], b = acc[ai][bj][m][1];
                        u32x2 w; w.x = cvt_pk_bf16(siluf_(a[0]) * b[0], siluf_(a[1]) * b[1]); w.y = cvt_pk_bf16(siluf_(a[2]) * b[2], siluf_(a[3]) * b[3]);
                        *(u32x2*)(rowp + bj * 64) = w; }
                }
            }
    }
};

template <class Epi, class Sched, bool GATHER>
__device__ __forceinline__ void gemm_phase(LAS unsigned char* lds, const int Kin, const int lda, const Sched& S, const Epi& E, const int gclamp) {
    int K = Kin; asm volatile("" : "+s"(K));
    const int tid = tid_(), wid = __builtin_amdgcn_readfirstlane(tid >> 6), lane = tid & 63, wr = wid >> 2, wc = wid & 3, fr = lane & 15, fq = lane >> 4;
    const int nt = K / BK;
    int Rr[2], Cc[2]; unsigned voffB[2];
#pragma unroll
    for (int i = 0; i < 2; ++i) { int R, C; stage_rc(tid * 16 + i * 8192, R, C); const int Rb = (R & ~31) + perm32(R & 31); Rr[i] = R; Cc[i] = C; voffB[i] = (unsigned)(Rb * K + C) * 2u; }
    const size_t kstep = (size_t)(BK * 2);
    const size_t hstepB = (size_t)HALF * K * 2;
    const unsigned ldsw = (unsigned)wid * 1024u;
    const int aoff = lds_byte(wr * 64 + fr, fq * 8), boff = lds_byte(wc * 32 + fr, fq * 8);
#define PG8_SA(b, h) (((b) * 2 + (h)) * HTB)
#define PG8_SB(b, h) ((4 + (b) * 2 + (h)) * HTB)
#define PG8_STAGE(bufoff, gbase, voff) do { _Pragma("unroll") for (int _i = 0; _i < 2; ++_i) \
        __builtin_amdgcn_global_load_lds((const unsigned*)((const char*)(gbase) + (voff)[_i]), (LAS unsigned*)(lds + (bufoff) + ldsw + _i * 8192), 16, 0, 0); } while (0)
#define PG8_LDA(dst, b, h) do { _Pragma("unroll") for (int m = 0; m < 4; ++m) _Pragma("unroll") for (int k = 0; k < 2; ++k) dst[m][k] = *(const LAS bf16x8*)(lds + PG8_SA(b, h) + aoff + m * 2048 + k * 1024); } while (0)
#define PG8_LDB(dst, b, h) do { _Pragma("unroll") for (int n = 0; n < 2; ++n) _Pragma("unroll") for (int k = 0; k < 2; ++k) dst[n][k] = *(const LAS bf16x8*)(lds + PG8_SB(b, h) + boff + n * 2048 + k * 1024); } while (0)
#define PG8_MMA(ai, bj, At, Bt) do { __builtin_amdgcn_s_setprio(1); _Pragma("unroll") for (int m = 0; m < 4; ++m) _Pragma("unroll") for (int n = 0; n < 2; ++n) _Pragma("unroll") for (int k = 0; k < 2; ++k) \
        acc[ai][bj][m][n] = __builtin_amdgcn_mfma_f32_16x16x32_bf16(Bt[n][k], At[m][k], acc[ai][bj][m][n], 0, 0, 0); __builtin_amdgcn_s_setprio(0); } while (0)
#define PG8_WAIT_V(n) asm volatile("s_waitcnt vmcnt(" #n ")" ::: "memory")
#define PG8_WAIT_L(n) asm volatile("s_waitcnt lgkmcnt(" #n ")" ::: "memory")
#define PG8_BAR __builtin_amdgcn_s_barrier()
#define PG8_SCHED __builtin_amdgcn_sched_barrier(0)
#define PG8_AOFF(dst, u) do { _Pragma("unroll") for (int _h = 0; _h < 2; ++_h) _Pragma("unroll") for (int _i = 0; _i < 2; ++_i) { \
        int _r = Rr[_i] + _h * HALF; if (GATHER) { unsigned _t = (unsigned)(u).lst[_r]; _r = (int)(_t < (unsigned)gclamp ? _t : (unsigned)gclamp); } \
        dst[_h][_i] = ((unsigned)_r * (unsigned)lda + (unsigned)Cc[_i]) * 2u; } } while (0)
    Unit cur, nxt; int ui = 0;
    if (!S.next(0, cur)) return;
    unsigned vA[2][2], vN[2][2];
    PG8_AOFF(vA, cur);
    bool has_next = S.next(1, nxt);
    if (GATHER) {
        if (has_next) { PG8_AOFF(vN, nxt); } else {
#pragma unroll
            for (int h = 0; h < 2; ++h) { vN[h][0] = vA[h][0]; vN[h][1] = vA[h][1]; } }
    }
    f32x4 acc[2][2][4][2];
#pragma unroll
    for (int a = 0; a < 2; ++a)
#pragma unroll
        for (int b = 0; b < 2; ++b)
#pragma unroll
            for (int m = 0; m < 4; ++m)
#pragma unroll
                for (int n = 0; n < 2; ++n) acc[a][b][m][n] = (f32x4){0.f, 0.f, 0.f, 0.f};
    bf16x8 At[4][2], B0[2][2], B1[2][2];
    const char* cA = cur.a; const char* cB = cur.b;
    PG8_STAGE(PG8_SB(0, 0), cB, voffB); PG8_STAGE(PG8_SA(0, 0), cA, vA[0]); PG8_STAGE(PG8_SB(0, 1), cB + hstepB, voffB); PG8_STAGE(PG8_SA(0, 1), cA, vA[1]);
    if (wr == 1) PG8_BAR;
    PG8_WAIT_V(4); PG8_BAR;
    PG8_STAGE(PG8_SB(1, 0), cB + kstep, voffB); PG8_STAGE(PG8_SA(1, 0), cA + kstep, vA[0]); PG8_STAGE(PG8_SB(1, 1), cB + hstepB + kstep, voffB);
    PG8_WAIT_V(6); PG8_BAR;
    for (;;) {
        const char* nA = has_next ? nxt.a : cA; const char* nB = has_next ? nxt.b : cB;
        for (int t = 0; t < nt; t += 2) {
            const bool last = (t == nt - 2);
            const char* a1 = cA + (size_t)(t + 1) * kstep;
            const char* a2 = last ? nA : cA + (size_t)(t + 2) * kstep; const char* b2 = last ? nB : cB + (size_t)(t + 2) * kstep;
            const char* a3 = a2 + kstep; const char* b3 = b2 + kstep;
            unsigned v2[2][2];
#pragma unroll
            for (int h = 0; h < 2; ++h) { v2[h][0] = (GATHER && last) ? vN[h][0] : vA[h][0]; v2[h][1] = (GATHER && last) ? vN[h][1] : vA[h][1]; }
            PG8_LDB(B0, 0, 0); PG8_SCHED; PG8_LDA(At, 0, 0); PG8_STAGE(PG8_SA(1, 1), a1, vA[1]);
            PG8_WAIT_L(8); PG8_BAR; PG8_WAIT_L(0); PG8_MMA(0, 0, At, B0); PG8_BAR; PG8_SCHED;
            PG8_LDB(B1, 0, 1); PG8_STAGE(PG8_SB(0, 0), b2, voffB);
            PG8_BAR; PG8_WAIT_L(0); PG8_MMA(0, 1, At, B1); PG8_BAR;
            PG8_LDA(At, 0, 1); PG8_STAGE(PG8_SA(0, 0), a2, v2[0]);
            PG8_BAR; PG8_WAIT_L(0); PG8_MMA(1, 0, At, B0); PG8_BAR; PG8_SCHED;
            PG8_STAGE(PG8_SB(0, 1), b2 + hstepB, voffB);
            PG8_WAIT_V(6); PG8_BAR; PG8_MMA(1, 1, At, B1); PG8_BAR;
            PG8_LDB(B0, 1, 0); PG8_SCHED; PG8_LDA(At, 1, 0); PG8_STAGE(PG8_SA(0, 1), a2, v2[1]);
            PG8_WAIT_L(8); PG8_BAR; PG8_WAIT_L(0); PG8_MMA(0, 0, At, B0); PG8_BAR; PG8_SCHED;
            PG8_LDB(B1, 1, 1); PG8_STAGE(PG8_SB(1, 0), b3, voffB);
            PG8_BAR; PG8_WAIT_L(0); PG8_MMA(0, 1, At, B1); PG8_BAR;
            PG8_LDA(At, 1, 1); PG8_STAGE(PG8_SA(1, 0), a3, v2[0]);
            PG8_BAR; PG8_WAIT_L(0); PG8_MMA(1, 0, At, B0); PG8_BAR; PG8_SCHED;
            PG8_STAGE(PG8_SB(1, 1), b3 + hstepB, voffB);
            PG8_WAIT_V(6); PG8_BAR; PG8_MMA(1, 1, At, B1); PG8_BAR;
        }
        E(acc, cur, wr, wc, fr, fq);
        if (!has_next) break;
#pragma unroll
        for (int a = 0; a < 2; ++a)
#pragma unroll
            for (int b = 0; b < 2; ++b)
#pragma unroll
                for (int m = 0; m < 4; ++m)
#pragma unroll
                    for (int n = 0; n < 2; ++n) acc[a][b][m][n] = (f32x4){0.f, 0.f, 0.f, 0.f};
        cur = nxt; cA = nA; cB = nB; ++ui;
        if (GATHER) {
#pragma unroll
            for (int h = 0; h < 2; ++h) { vA[h][0] = vN[h][0]; vA[h][1] = vN[h][1]; } }
        has_next = S.next(ui + 1, nxt);
        if (GATHER && has_next) { PG8_AOFF(vN, nxt); }
    }
    PG8_WAIT_V(0);
    if (wr == 0) PG8_BAR;
    PG8_BAR;
#undef PG8_AOFF
#undef PG8_SA
#undef PG8_SB
#undef PG8_STAGE
#undef PG8_LDA
#undef PG8_LDB
#undef PG8_MMA
#undef PG8_WAIT_V
#undef PG8_WAIT_L
#undef PG8_BAR
#undef PG8_SCHED
}
}
constexpr int NTHR = 512;
constexpr int LDS_BYTES = 147456;
constexpr int LDS_MISC = 131072;

struct Frame {
    LAS unsigned char* lds;
    int tid, lane, wave, G, bid;
    unsigned char* ws;
    const float* const* in;
};

enum { I_X = 0, I_C, I_CTX, I_CCTX, I_MODW, I_MODB, I_WIN, I_WOUT, I_MU, I_W0, I_WUP, I_A0, I_AUP, I_GUP, I_KK, I_KA, I_RK, I_GNG, I_GNB,
       I_QN, I_KVN, I_WUQ, I_WUKV, I_RGG, I_RGB, I_LN1G, I_LN1B, I_LN2G, I_LN2B, I_RTW, I_RTB, I_W1, I_W3, I_W2 };

__device__ __forceinline__ float wave_sum(float v) {
#pragma unroll
    for (int o = 32; o >= 1; o >>= 1) v += __shfl_xor(v, o);
    return v;
}

__device__ __forceinline__ void mod_phase(const Params& p, LAS unsigned char* lds, int bid, int G) {
    const int tid = tid_(), lane = tid & 63, wv = tid >> 6;
    LAS float* S = (LAS float*)lds;
    float* MOD = (float*)(p.ws + WS_MOD);
    for (int u = bid; u < DEPTH * 96; u += G) {
        const int l = u / 96, col0 = (u % 96) * 128;
        const float* W = p.in[I_MODW] + (size_t)l * DM * 12288;
        float acc[17][2];
#pragma unroll
        for (int r = 0; r < 17; ++r) { acc[r][0] = 0.f; acc[r][1] = 0.f; }
        for (int half = 0; half < 2; ++half) {
            __syncthreads();
            for (int idx = tid; idx < 17 * 1024; idx += NTHR) { const int r = idx >> 10, kk = idx & 1023, k = half * 1024 + kk;
                const float v = (r < 16) ? p.in[I_C][r * DM + k] : p.in[I_CCTX][k]; S[idx] = siluf_(v); }
            __syncthreads();
            for (int kk = wv * 128; kk < wv * 128 + 128; kk += 8) {
                f32x2 w[8];
#pragma unroll
                for (int j = 0; j < 8; ++j) w[j] = __builtin_nontemporal_load((const f32x2*)(W + (size_t)(half * 1024 + kk + j) * 12288 + col0 + 2 * lane));
#pragma unroll
                for (int q4 = 0; q4 < 2; ++q4)
#pragma unroll
                    for (int r = 0; r < 17; ++r) { const f32x4 s = *(const LAS f32x4*)(S + r * 1024 + kk + 4 * q4);
                        acc[r][0] += s[0] * w[4 * q4][0] + s[1] * w[4 * q4 + 1][0] + s[2] * w[4 * q4 + 2][0] + s[3] * w[4 * q4 + 3][0];
                        acc[r][1] += s[0] * w[4 * q4][1] + s[1] * w[4 * q4 + 1][1] + s[2] * w[4 * q4 + 2][1] + s[3] * w[4 * q4 + 3][1]; }
            }
        }
        __syncthreads();
#pragma unroll
        for (int r = 0; r < 17; ++r) { S[(wv * 17 + r) * 128 + 2 * lane] = acc[r][0]; S[(wv * 17 + r) * 128 + 2 * lane + 1] = acc[r][1]; }
        __syncthreads();
        for (int idx = tid; idx < 17 * 128; idx += NTHR) { const int r = idx >> 7, cc = idx & 127; float s = 0.f;
#pragma unroll
            for (int w8 = 0; w8 < 8; ++w8) s += S[(w8 * 17 + r) * 128 + cc];
            MOD[((size_t)l * 17 + r) * 12288 + col0 + cc] = s + p.in[I_MODB][l * 12288 + col0 + cc]; }
    }
    __syncthreads();
}

__device__ __forceinline__ void rope_tables(const Params& p, int bid, int G) {
    float* COS = (float*)(p.ws + WS_COS); float* SIN = (float*)(p.ws + WS_SIN);
    for (int idx = bid * NTHR + tid_(); idx < 2048 * 32; idx += G * NTHR) {
        const int pos = idx >> 5, i = idx & 31; const int row = pos >> 6, col = pos & 63;
        const float inv = powf(10000.0f, -(float)(i & 15) / 16.0f);
        const float ang = (float)(i < 16 ? row : col) * inv;
        COS[idx] = cosf(ang); SIN[idx] = sinf(ang);
    }
}

template <class F>
__device__ __forceinline__ void cvt_tiles(LAS unsigned char* lds, bf16_t* dst, int N, int K, F src4, int& ctr, int bid, int G) {
    LAS bf16_t* T = (LAS bf16_t*)lds;
    const int tid = tid_(), nk = K >> 6, nun = (N >> 7) * nk;
    int u0 = (bid - ctr) % G; if (u0 < 0) u0 += G;
    ctr = (ctr + nun) % G;
    for (int u = u0; u < nun; u += G) {
        const int n0 = (u / nk) << 7, k0 = (u % nk) << 6;
        f32x4 v[4];
#pragma unroll
        for (int j = 0; j < 4; ++j) { const int e = tid + NTHR * j; v[j] = src4(k0 + (e >> 5), n0 + (e & 31) * 4); }
        __syncthreads();
#pragma unroll
        for (int j = 0; j < 4; ++j) { const int e = tid + NTHR * j, kl = e >> 5, nl = (e & 31) * 4;
#pragma unroll
            for (int i = 0; i < 4; ++i) T[(nl + i) * 66 + kl] = f2bf(v[j][i]); }
        __syncthreads();
#pragma unroll
        for (int jj = 0; jj < 2; ++jj) { const int idx = tid + NTHR * jj, nl = idx >> 3, kc = (idx & 7) * 8; u32x4 w; const LAS unsigned* tp = (const LAS unsigned*)(T + nl * 66 + kc);
          w.x = tp[0]; w.y = tp[1]; w.z = tp[2]; w.w = tp[3]; *(u32x4*)(dst + (size_t)(n0 + nl) * K + k0 + kc) = w; }
    }
}

__device__ __forceinline__ int win_srccol(int n) {
    if (n < 1536) return n;
    if (n < 2048) return 1760 + (n - 1536);
    if (n < 2304) return 2272 + (n - 2048);
    if (n < 2560) { const int j = n - 2304, d = j & 63; return 2592 + (j & ~63) + (d >> 1) + 32 * (d & 1); }
    if (n < 2816) { const int j = n - 2560, d = j & 63; return 2848 + (j & ~63) + (d >> 1) + 32 * (d & 1); }
    if (n < 3328) return 3104 + (n - 2816);
    if (n < 3840) return 3616 + (n - 3328);
    if (n < 3904) return 1536 + (n - 3840);
    if (n < 3968) return 1600 + (n - 3904);
    if (n < 4064) return 1664 + (n - 3968);
    if (n < 4128) { const int d = n - 4064; return 2528 + (d >> 1) + 32 * (d & 1); }
    return -1;
}

__device__ __forceinline__ void convert_weights(const Params& p, LAS unsigned char* lds, int l, int bid, int G) {
    int ctr = 0;
    { const float* w = p.in[I_WIN] + (size_t)l * DM * IN_COLS;
      cvt_tiles(lds, (bf16_t*)(p.ws + WS_WIN), NPC, DM, [=](int k, int n) -> f32x4 {
          const float* r = w + (size_t)k * IN_COLS;
          const bool inter = (n >= 2304 && n < 2816) || n >= 4064;
          if (!inter) return *(const f32x4*)(r + win_srccol(n));
          f32x4 o;
#pragma unroll
          for (int i = 0; i < 4; ++i) { const int sc = win_srccol(n + i); o[i] = sc < 0 ? 0.0f : r[sc < 0 ? 0 : sc]; }
          return o; }, ctr, bid, G); }
    { const float* w = p.in[I_WOUT] + (size_t)l * DM * DM;
      cvt_tiles(lds, (bf16_t*)(p.ws + WS_WOUT), DM, DM, [=](int k, int n) -> f32x4 { return *(const f32x4*)(w + (size_t)k * DM + n); }, ctr, bid, G); }
    { const float* w = p.in[I_WUQ] + (size_t)l * 512 * 1536; const float* g = p.in[I_QN] + l * 512;
      cvt_tiles(lds, (bf16_t*)(p.ws + WS_WUQ), 1536, 512, [=](int k, int n) -> f32x4 { const int h = n / 192, d = n % 192; const float* r = w + (size_t)k * 1536 + h * 192; const float gk = g[k];
          if (d < 128) return *(const f32x4*)(r + d) * gk;
          f32x4 o;
#pragma unroll
          for (int i = 0; i < 4; ++i) { const int dd = d - 128 + i; o[i] = r[128 + (dd >> 1) + 32 * (dd & 1)] * gk; }
          return o; }, ctr, bid, G); }
    { const float* w = p.in[I_WUKV] + (size_t)l * 256 * 2048; const float* g = p.in[I_KVN] + l * 256;
      cvt_tiles(lds, (bf16_t*)(p.ws + WS_WUKV), 2048, 256, [=](int k, int n) -> f32x4 { return *(const f32x4*)(w + (size_t)k * 2048 + n) * g[k]; }, ctr, bid, G); }
    for (int e = 0; e < NEXP; ++e) {
        const float* w1 = p.in[I_W1] + ((size_t)l * NEXP + e) * DM * DEXP; const float* w3 = p.in[I_W3] + ((size_t)l * NEXP + e) * DM * DEXP;
        cvt_tiles(lds, (bf16_t*)(p.ws + WS_W13) + (size_t)e * 1024 * DM, 1024, DM, [=](int k, int n) -> f32x4 { const int j = (n >> 3) << 2;
            const float* r = ((n >> 2) & 1) ? w3 : w1; return *(const f32x4*)(r + (size_t)k * DEXP + j); }, ctr, bid, G);
    }
    for (int e = 0; e < NEXP; ++e) {
        const float* w2 = p.in[I_W2] + ((size_t)l * NEXP + e) * DEXP * DM;
        cvt_tiles(lds, (bf16_t*)(p.ws + WS_W2) + (size_t)e * DM * DEXP, DM, DEXP, [=](int k, int n) -> f32x4 { return *(const f32x4*)(w2 + (size_t)k * DM + n); }, ctr, bid, G);
    }
    __syncthreads();
    { bf16_t* WUP = (bf16_t*)(p.ws + WS_WUP); bf16_t* AUP = (bf16_t*)(p.ws + WS_AUP); bf16_t* GUP = (bf16_t*)(p.ws + WS_GUP);
      const float* wu = p.in[I_WUP] + (size_t)l * 2 * 32 * 512; const float* au = p.in[I_AUP] + (size_t)l * 2 * 32 * 512; const float* gu = p.in[I_GUP] + (size_t)l * 96 * 512;
      for (int idx = bid * NTHR + tid_(); idx < 2 * 512 * 32; idx += G * NTHR) { const int d = idx >> 14, c = (idx >> 5) & 511, r = idx & 31;
          WUP[idx] = f2bf(wu[((size_t)d * 32 + r) * 512 + c]); AUP[idx] = f2bf(au[((size_t)d * 32 + r) * 512 + c]); }
      for (int idx = bid * NTHR + tid_(); idx < 512 * 96; idx += G * NTHR) { const int c = idx / 96, r = idx % 96; GUP[idx] = f2bf(gu[(size_t)r * 512 + c]); }
    }
}
#define DPP_ADD(v, ctrl) ((v) + __builtin_bit_cast(float, __builtin_amdgcn_update_dpp(0, __builtin_bit_cast(int, (v)), (ctrl), 0xF, 0xF, true)))
__device__ __forceinline__ float row16_sum(float v) {
    v = DPP_ADD(v, 0xB1); v = DPP_ADD(v, 0x4E); v = DPP_ADD(v, 0x141); v = DPP_ADD(v, 0x140); return v;
}
__device__ __forceinline__ float red8(float v) {
    v = DPP_ADD(v, 0xB1); v = DPP_ADD(v, 0x4E); v = DPP_ADD(v, 0x141); return v;
}
__device__ __forceinline__ f32x2 red8x2(f32x2 v) {
    float a = v[0], b = v[1];
    a = DPP_ADD(a, 0xB1); b = DPP_ADD(b, 0xB1); a = DPP_ADD(a, 0x4E); b = DPP_ADD(b, 0x4E); a = DPP_ADD(a, 0x141); b = DPP_ADD(b, 0x141);
    return (f32x2){a, b};
}
__device__ __forceinline__ float rows4_sum(float v) {
    { auto r = __builtin_amdgcn_permlane16_swap(__float_as_uint(v), __float_as_uint(v), false, false); v = __uint_as_float(r[0]) + __uint_as_float(r[1]); }
    { auto r = __builtin_amdgcn_permlane32_swap(__float_as_uint(v), __float_as_uint(v), false, false); v = __uint_as_float(r[0]) + __uint_as_float(r[1]); }
    return v;
}
__device__ __forceinline__ float wsum(float v) {
    v = row16_sum(v);
    return __builtin_bit_cast(float, __builtin_amdgcn_readlane(__builtin_bit_cast(int, v), 0)) + __builtin_bit_cast(float, __builtin_amdgcn_readlane(__builtin_bit_cast(int, v), 16)) +
           __builtin_bit_cast(float, __builtin_amdgcn_readlane(__builtin_bit_cast(int, v), 32)) + __builtin_bit_cast(float, __builtin_amdgcn_readlane(__builtin_bit_cast(int, v), 48));
}

__device__ __forceinline__ f32x4 load_bf4(const bf16_t* src);
__device__ __forceinline__ f32x4 unpack_bf4(const u32x2 w) { f32x4 r; r[0] = __uint_as_float(w.x << 16); r[1] = __uint_as_float(w.x & 0xffff0000u); r[2] = __uint_as_float(w.y << 16); r[3] = __uint_as_float(w.y & 0xffff0000u); return r; }
__device__ __forceinline__ const float* xrow_in(const Params& p, int m) {
    const int b = m / LT, t = m % LT;
    if (t < LC) return p.in[I_CTX] + ((size_t)b * LC + t) * DM;
    return p.in[I_X] + ((size_t)b * LL + (t - LC)) * DM;
}
__device__ __forceinline__ f32x4 xs_load(const Params& p, int m, int l, int e) {
    if (l == 0) return *(const f32x4*)(xrow_in(p, m) + e);
    return load_bf4((const bf16_t*)(p.ws + WS_XB) + (size_t)m * DM + e);
}
__device__ __forceinline__ const float* mod_ptr(const Params& p, int l, int m, int which) {
    const int b = m / LT, t = m % LT; const int row = (t < LC) ? 16 : b;
    return (const float*)(p.ws + WS_MOD) + ((size_t)l * 17 + row) * 12288 + which * DM;
}
__device__ __forceinline__ void store_bf4(bf16_t* dst, const f32x4 v) { u32x2 w; w.x = cvt_pk_bf16(v[0], v[1]); w.y = cvt_pk_bf16(v[2], v[3]); *(u32x2*)dst = w; }
__device__ __forceinline__ f32x4 load_bf4(const bf16_t* src) { const u32x2 w = *(const u32x2*)src; f32x4 r; r[0] = __uint_as_float(w.x << 16); r[1] = __uint_as_float(w.x & 0xffff0000u);
    r[2] = __uint_as_float(w.y << 16); r[3] = __uint_as_float(w.y & 0xffff0000u); return r; }

__device__ __forceinline__ f32x4 load_bf4_lds(const LAS bf16_t* src) { const u32x2 w = *(const LAS u32x2*)src; f32x4 r; r[0] = __uint_as_float(w.x << 16); r[1] = __uint_as_float(w.x & 0xffff0000u);
    r[2] = __uint_as_float(w.y << 16); r[3] = __uint_as_float(w.y & 0xffff0000u); return r; }
__device__ __forceinline__ void modulate_phase(const Params& p, int l, int bid, int G) {
    const int tid = tid_(), lane = tid & 63, wv = tid >> 6;
    bf16_t* ACT = (bf16_t*)(p.ws + WS_ACT);
    for (int m = bid * 8 + wv; m < MT; m += G * 8) {
        const float* x = xrow_in(p, m); const float* sh = mod_ptr(p, l, m, 0); const float* sc = mod_ptr(p, l, m, 1);
#pragma unroll
        for (int j = 0; j < 8; ++j) { const int e = j * 256 + lane * 4;
            const f32x4 xv = *(const f32x4*)(x + e), s = *(const f32x4*)(sc + e), h = *(const f32x4*)(sh + e);
            store_bf4(ACT + (size_t)m * DM + e, xv * (1.0f + s) + h); }
    }
}

__device__ __forceinline__ void moe_prefix(const Params& p, LAS unsigned char* lds, int l) {
    LAS int* toff = (LAS int*)(lds + LDS_MISC + 64);
    const int tid = tid_();
    __syncthreads();
    if (tid < 64) {
        const unsigned* cnt = (const unsigned*)(p.ws + WS_CTL) + CW_CNT + l * 16 * 64;
        const unsigned c = (tid < NEXP) ? __hip_atomic_load(cnt + tid * 64, __ATOMIC_RELAXED, __HIP_MEMORY_SCOPE_AGENT) : 0u;
        const int tiles = (int)((c + 255u) >> 8); int s = 0;
#pragma unroll
        for (int e = 0; e < NEXP; ++e) { const int te = __builtin_amdgcn_readlane(tiles, e); if (tid == e) toff[e] = s; s += te; }
        if (tid == 0) toff[16] = s;
    }
    __syncthreads();
}

struct RowSel { int e0, e1; float w0, w1; };
__device__ __forceinline__ RowSel route_row(const float (&lgt)[16], const float* __restrict__ rtb) {
    float sg[16], sb[16];
#pragma unroll
    for (int e16 = 0; e16 < 16; ++e16) { sg[e16] = sigmoidf_(lgt[e16]); sb[e16] = sg[e16] + rtb[e16]; }
    int best = 0; float bestv = -1e30f;
#pragma unroll
    for (int g = 0; g < 4; ++g) { const float a = sb[4 * g], b = sb[4 * g + 1], c = sb[4 * g + 2], d = sb[4 * g + 3];
        const float hi1 = fmaxf(a, b), lo1 = fminf(a, b), hi2 = fmaxf(c, d), lo2 = fminf(c, d);
        const float top = fmaxf(hi1, hi2), second = fmaxf(fminf(hi1, hi2), hi1 >= hi2 ? lo1 : lo2);
        const float gs = top + second; if (gs > bestv) { bestv = gs; best = g; } }
    float gb[4], gsv[4];
#pragma unroll
    for (int i = 0; i < 4; ++i) { gb[i] = 0.f; gsv[i] = 0.f; }
#pragma unroll
    for (int g = 0; g < 4; ++g) if (g == best) {
#pragma unroll
        for (int i = 0; i < 4; ++i) { gb[i] = sb[4 * g + i]; gsv[i] = sg[4 * g + i]; } }
    int i0 = 0; float b0 = gb[0];
#pragma unroll
    for (int i = 1; i < 4; ++i) if (gb[i] > b0) { b0 = gb[i]; i0 = i; }
    int i1 = -1; float b1 = -1e30f;
#pragma unroll
    for (int i = 0; i < 4; ++i) if (i != i0 && gb[i] > b1) { b1 = gb[i]; i1 = i; }
    float s0 = 0.f, s1 = 0.f;
#pragma unroll
    for (int i = 0; i < 4; ++i) { if (i == i0) s0 = gsv[i]; if (i == i1) s1 = gsv[i]; }
    const float inv = 2.5f / (s0 + s1);
    RowSel r; r.e0 = best * 4 + i0; r.e1 = best * 4 + i1; r.w0 = s0 * inv; r.w1 = s1 * inv; return r;
}
__device__ __forceinline__ float sum4(const f32x4 v) { return (v[0] + v[1]) + (v[2] + v[3]); }
__device__ __forceinline__ float sq4(const f32x4 v) { return (v[0] * v[0] + v[1] * v[1]) + (v[2] * v[2] + v[3] * v[3]); }

template <int MODE>
__device__ __forceinline__ void ln1_phase(const Params& p, LAS unsigned char* lds, int l, int bid, int G) {
    const int tid = tid_(), lane = tid & 63, wv = tid >> 6;
    LAS float* RW = (LAS float*)lds;
    __syncthreads();
    { f32x4 t[16];
#pragma unroll
      for (int j = 0; j < 16; ++j) t[j] = ((const f32x4*)p.in[I_RTW])[tid + NTHR * j];
#pragma unroll
      for (int j = 0; j < 16; ++j) { const int i = tid + NTHR * j, d = i >> 2, c = i & 3, dp = (d & 3) * 512 + (d >> 2);
          ((LAS f32x4*)RW)[dp * 4 + ((c + (dp >> 2)) & 3)] = t[j]; } }
    __syncthreads();
    int po[4];
#pragma unroll
    for (int c = 0; c < 4; ++c) po[c] = (c + (lane >> 2)) & 3;
    bf16_t* ACT = (bf16_t*)(p.ws + WS_ACT); const bf16_t* MO = (const bf16_t*)(p.ws + WS_MO); bf16_t* XB = (bf16_t*)(p.ws + WS_XB);
    int* LIST = (int*)(p.ws + WS_LIST); int* TINF = (int*)(p.ws + WS_TINF);
    unsigned* cnt = (unsigned*)(p.ws + WS_CTL) + CW_CNT + l * 16 * 64;
    LAS unsigned* lcnt = (LAS unsigned*)(lds + LDS_MISC + 256);
    LAS int* rinfo = (LAS int*)(lds + LDS_MISC + 1024);
    if (tid < 32) lcnt[tid] = 0u;
    __syncthreads();
    int nrow = 0;
    const float* lg = p.in[I_LN1G] + l * DM; const float* lb = p.in[I_LN1B] + l * DM; const float* rtb = p.in[I_RTB];
    const int rpw = (((MT + G - 1) / G) + 1) & ~1, rbase = bid * rpw;
    u32x2 mo_n[8], x_n[8];
    { const int mf = (rbase + wv < MT) ? rbase + wv : 0;
#pragma unroll
      for (int j = 0; j < 8; ++j) { const int e = j * 256 + lane * 4; mo_n[j] = *(const u32x2*)(MO + (size_t)mf * DM + e); x_n[j] = (l > 0) ? *(const u32x2*)(XB + (size_t)mf * DM + e) : (u32x2){0u, 0u}; } }
    for (int ri_ = wv; ri_ < rpw; ri_ += 8) {
        const int m = rbase + ri_; if (m >= MT) break;
        u32x2 mo_c[8], x_c[8];
#pragma unroll
        for (int j = 0; j < 8; ++j) { mo_c[j] = mo_n[j]; x_c[j] = x_n[j]; }
        { const int mn = (ri_ + 8 < rpw && m + 8 < MT) ? m + 8 : m;
#pragma unroll
          for (int j = 0; j < 8; ++j) { const int e = j * 256 + lane * 4; mo_n[j] = *(const u32x2*)(MO + (size_t)mn * DM + e); x_n[j] = (l > 0) ? *(const u32x2*)(XB + (size_t)mn * DM + e) : (u32x2){0u, 0u}; } }
        if (l == DEPTH - 1 && (m % LT) < LC) continue;
        const float* g1 = mod_ptr(p, l, m, 2); const float* sh2 = mod_ptr(p, l, m, 3); const float* sc2 = mod_ptr(p, l, m, 4);
        f32x4 v[8]; float s_ = 0.f;
#pragma unroll
        for (int j = 0; j < 8; ++j) { const int e = j * 256 + lane * 4;
            const f32x4 xv = (l > 0) ? unpack_bf4(x_c[j]) : *(const f32x4*)(xrow_in(p, m) + e);
            v[j] = ALPHA_F * xv + *(const f32x4*)(g1 + e) * unpack_bf4(mo_c[j]);
            s_ += sum4(v[j]); }
        f32x4 gg = *(const f32x4*)(lg + lane * 4), bb = *(const f32x4*)(lb + lane * 4), sc = *(const f32x4*)(sc2 + lane * 4), sh = *(const f32x4*)(sh2 + lane * 4);
        const float mean = wsum(s_) * (1.0f / DM); float q = 0.f;
#pragma unroll
        for (int j = 0; j < 8; ++j) { v[j] = v[j] - mean; q += sq4(v[j]); }
        const float rstd = rsqrtf(wsum(q) * (1.0f / DM) + LN_EPS_F);
        float lgt[16];
#pragma unroll
        for (int e16 = 0; e16 < 16; ++e16) lgt[e16] = 0.f;
#pragma unroll
        for (int j = 0; j < 8; ++j) { const int e = j * 256 + lane * 4, en = (j < 7 ? j + 1 : j) * 256 + lane * 4;
            const f32x4 ggn = *(const f32x4*)(lg + en), bbn = *(const f32x4*)(lb + en), scn = *(const f32x4*)(sc2 + en), shn = *(const f32x4*)(sh2 + en);
            const f32x4 x1 = v[j] * rstd * gg + bb;
            if (MODE == 0) store_bf4(XB + (size_t)m * DM + e, x1);
            const f32x4 u = x1 * (1.0f + sc) + sh;
            if (MODE == 0) store_bf4(ACT + (size_t)m * DM + e, u);
#pragma unroll
            for (int i = 0; i < 4; ++i) {
                const LAS f32x4* rw = (const LAS f32x4*)(RW + (i * 512 + j * 64 + lane) * 16);
                const f32x4 r0 = rw[po[0]], r1 = rw[po[1]], r2 = rw[po[2]], r3 = rw[po[3]];
#pragma unroll
                for (int c = 0; c < 4; ++c) { lgt[c] += u[i] * r0[c]; lgt[4 + c] += u[i] * r1[c]; lgt[8 + c] += u[i] * r2[c]; lgt[12 + c] += u[i] * r3[c]; }
            }
            gg = ggn; bb = bbn; sc = scn; sh = shn;
            __builtin_amdgcn_sched_barrier(0);
        }
#pragma unroll
        for (int e16 = 0; e16 < 16; ++e16) lgt[e16] = wsum(lgt[e16]);
        const RowSel ra = route_row(lgt, rtb);
        if (MODE != 0) { asm volatile("" :: "v"(ra.e0), "v"(ra.e1), "v"(ra.w0), "v"(ra.w1)); }
        if (MODE == 0 && lane == 0) {
            const unsigned r0 = __hip_atomic_fetch_add(lcnt + ra.e0, 1u, __ATOMIC_RELAXED, __HIP_MEMORY_SCOPE_WORKGROUP), r1 = __hip_atomic_fetch_add(lcnt + ra.e1, 1u, __ATOMIC_RELAXED, __HIP_MEMORY_SCOPE_WORKGROUP);
            LAS int* ri = rinfo + (wv * 64 + nrow) * 4; ri[0] = ra.e0; ri[1] = (int)r0; ri[2] = ra.e1; ri[3] = (int)r1;
            int* ti = TINF + (size_t)m * 8; ti[0] = ra.e0; ti[2] = ra.e1; ti[4] = __float_as_int(ra.w0); ti[5] = __float_as_int(ra.w1);
        }
        ++nrow;
    }
    __syncthreads();
    if (MODE != 0) return;
    if (tid < NEXP) lcnt[16 + tid] = __hip_atomic_fetch_add(cnt + tid * 64, lcnt[tid], __ATOMIC_RELAXED, __HIP_MEMORY_SCOPE_AGENT);
    __syncthreads();
    { int k = 0;
      for (int ri_ = wv; ri_ < rpw; ri_ += 8) {
        const int m = rbase + ri_; if (m >= MT) break;
        if (l == DEPTH - 1 && (m % LT) < LC) continue;
        if (lane == (k & 63)) { const LAS int* ri = rinfo + (wv * 64 + k) * 4; const int e0 = ri[0], e1 = ri[2];
            const int s0_ = (int)lcnt[16 + e0] + ri[1], s1_ = (int)lcnt[16 + e1] + ri[3];
            int* ti = TINF + (size_t)m * 8; ti[1] = s0_; ti[3] = s1_; LIST[(size_t)e0 * MT + s0_] = m; LIST[(size_t)e1 * MT + s1_] = m; }
        ++k; } }
    __syncthreads();
}

template <int MODE>
__device__ __forceinline__ void ln2_phase(const Params& p, LAS unsigned char* lds, int l, int bid, int G) {
    const int tid = tid_(), lane = tid & 63, wv = tid >> 6;
    moe_prefix(p, lds, l);
    const LAS int* toff = (const LAS int*)(lds + LDS_MISC + 64);
    bf16_t* ACT = (bf16_t*)(p.ws + WS_ACT); const bf16_t* Y = (const bf16_t*)(p.ws + WS_Y); const int* TINF = (const int*)(p.ws + WS_TINF); bf16_t* XB = (bf16_t*)(p.ws + WS_XB);
    const float* lg = p.in[I_LN2G] + l * DM; const float* lb = p.in[I_LN2B] + l * DM;
    const int rpw = (((MT + G - 1) / G) + 1) & ~1, rbase = bid * rpw;
    for (int pi = wv; 2 * pi < rpw; pi += 8) {
        const int m = rbase + 2 * pi; if (m >= MT) break;
        if (l == DEPTH - 1 && (m % LT) < LC) continue;
        const float* g2 = mod_ptr(p, l, m, 5);
        float* xf = p.out + ((size_t)(m / LT) * LL + ((m % LT) - LC)) * DM;
        const int* ti = TINF + (size_t)m * 8;
        const int ea0 = ti[0], sa0 = ti[1], ea1 = ti[2], sa1 = ti[3]; const float wa0 = __int_as_float(ti[4]), wa1 = __int_as_float(ti[5]);
        const int eb0 = ti[8], sb0 = ti[9], eb1 = ti[10], sb1 = ti[11]; const float wb0 = __int_as_float(ti[12]), wb1 = __int_as_float(ti[13]);
        const bf16_t* ya0 = Y + ((size_t)toff[ea0] * 256 + sa0) * DM; const bf16_t* ya1 = Y + ((size_t)toff[ea1] * 256 + sa1) * DM;
        const bf16_t* yb0 = Y + ((size_t)toff[eb0] * 256 + sb0) * DM; const bf16_t* yb1 = Y + ((size_t)toff[eb1] * 256 + sb1) * DM;
        f32x4 va[8], vb[8]; float sa_ = 0.f, sb_ = 0.f;
#pragma unroll
        for (int j = 0; j < 8; ++j) { const int e = j * 256 + lane * 4; const f32x4 g = *(const f32x4*)(g2 + e);
            va[j] = ALPHA_F * load_bf4(XB + (size_t)m * DM + e) + g * (wa0 * load_bf4(ya0 + e) + wa1 * load_bf4(ya1 + e));
            vb[j] = ALPHA_F * load_bf4(XB + (size_t)(m + 1) * DM + e) + g * (wb0 * load_bf4(yb0 + e) + wb1 * load_bf4(yb1 + e));
            sa_ += sum4(va[j]); sb_ += sum4(vb[j]); }
        const float meana = wsum(sa_) * (1.0f / DM), meanb = wsum(sb_) * (1.0f / DM); float qa = 0.f, qb = 0.f;
#pragma unroll
        for (int j = 0; j < 8; ++j) { va[j] = va[j] - meana; vb[j] = vb[j] - meanb; qa += sq4(va[j]); qb += sq4(vb[j]); }
        const float rstda = rsqrtf(wsum(qa) * (1.0f / DM) + LN_EPS_F), rstdb = rsqrtf(wsum(qb) * (1.0f / DM) + LN_EPS_F);
        const float* sh = (l + 1 < DEPTH) ? mod_ptr(p, l + 1, m, 0) : nullptr; const float* sc = (l + 1 < DEPTH) ? mod_ptr(p, l + 1, m, 1) : nullptr;
#pragma unroll
        for (int j = 0; j < 8; ++j) { const int e = j * 256 + lane * 4;
            const f32x4 gg = *(const f32x4*)(lg + e), bb = *(const f32x4*)(lb + e);
            const f32x4 xa = va[j] * rstda * gg + bb, xb = vb[j] * rstdb * gg + bb;
            if (MODE != 0) { asm volatile("" :: "v"(xa), "v"(xb)); }
            else if (l + 1 < DEPTH) { const f32x4 s1 = 1.0f + *(const f32x4*)(sc + e), h1 = *(const f32x4*)(sh + e);
                store_bf4(XB + (size_t)m * DM + e, xa); store_bf4(XB + (size_t)(m + 1) * DM + e, xb);
                store_bf4(ACT + (size_t)m * DM + e, xa * s1 + h1); store_bf4(ACT + (size_t)(m + 1) * DM + e, xb * s1 + h1); }
            else { *(f32x4*)(xf + e) = xa; *(f32x4*)(xf + DM + e) = xb; } }
    }
}
template <int MODE>
__device__ __forceinline__ void prep_phase(const Params& p, LAS unsigned char* lds, int l, int bid, int G) {
    const int tid0 = tid_(), lane = tid0 & 63, wv = __builtin_amdgcn_readfirstlane(tid0 >> 6);
    constexpr int RW_P = 1768;
    LAS bf16_t* RAW = (LAS bf16_t*)lds;
    LAS bf16_t* ACTW = (LAS bf16_t*)(lds + 65536);
    LAS bf16_t* ACTA = (LAS bf16_t*)(lds + 65536 + 2048);
    LAS bf16_t* ACTG = (LAS bf16_t*)(lds + 65536 + 4096);
    const bf16_t* P = (const bf16_t*)(p.ws + WS_P);
    bf16_t* OPS = (bf16_t*)(p.ws + WS_OPS); bf16_t* Gb = (bf16_t*)(p.ws + WS_G); float* BON = (float*)(p.ws + WS_BON);
    bf16_t* VSH = (bf16_t*)(p.ws + WS_VSH);
    float* RSQ = (float*)(p.ws + WS_RSQ); float* RSKV = (float*)(p.ws + WS_RSKV);
    bf16_t* KR = (bf16_t*)(p.ws + WS_KR); bf16_t* RQ = (bf16_t*)(p.ws + WS_RQ); bf16_t* RK = (bf16_t*)(p.ws + WS_RK);
    const float* COS = (const float*)(p.ws + WS_COS); const float* SIN = (const float*)(p.ws + WS_SIN);
    const float* mu = p.in[I_MU] + l * 1760;
    const bf16_t* WUP = (const bf16_t*)(p.ws + WS_WUP); const bf16_t* AUP = (const bf16_t*)(p.ws + WS_AUP); const bf16_t* GUP = (const bf16_t*)(p.ws + WS_GUP);
    const float* w0 = p.in[I_W0] + l * 1024; const float* a0 = p.in[I_A0] + l * 1024;
    const float* kkp = p.in[I_KK] + l * 512; const float* kap = p.in[I_KA] + l * 512; const float* rkp = p.in[I_RK] + l * 512;
    for (int unit = bid; unit < MT / 16; unit += G) {
        const int tid = tid_();
        const int m0 = unit * 16, t0 = m0 % LT; const bool isctx = t0 < LC; const int seg_lo = isctx ? 0 : LC, seg_hi = isctx ? LC : LT;
        __syncthreads();
        { bf16x8 tmp[8];
#pragma unroll
          for (int j = 0; j < 8; ++j) { const int item = tid + NTHR * j, rr = item / 220, cc = item % 220; const int t = t0 - 1 + rr;
              const int pc = cc < 192 ? cc * 8 : PC_WD + (cc - 192) * 8;
              bf16x8 z;
#pragma unroll
              for (int i = 0; i < 8; ++i) z[i] = 0;
              tmp[j] = (item < 18 * 220 && t >= seg_lo && t < seg_hi) ? *(const bf16x8*)(P + ((size_t)m0 - 1 + rr) * NPC + pc) : z; }
#pragma unroll
          for (int j = 0; j < 8; ++j) { const int item = tid + NTHR * j, rr = item / 220, cc = item % 220;
              if (item < 18 * 220) *(LAS bf16x8*)(RAW + rr * RW_P + cc * 8) = tmp[j]; } }
        { bf16x8 cq_[2], ck_[2]; unsigned kw_, rw_[4]; float kc_ = 1.f, ks_ = 0.f, rc_[4], rs_[4];
#pragma unroll
          for (int tt = 0; tt < 2; ++tt) { const size_t m = (size_t)m0 + wv * 2 + tt; cq_[tt] = *(const bf16x8*)(P + m * NPC + PC_CQ + lane * 8); ck_[tt] = *(const bf16x8*)(P + m * NPC + PC_CKV + (lane & 31) * 8); }
          { const int tok = tid >> 5, pi = tid & 31; const size_t m = (size_t)m0 + tok; kw_ = *(const unsigned*)(P + m * NPC + PC_KR + 2 * pi);
            if (!isctx) { const int pos = t0 + tok - LC; kc_ = COS[pos * 32 + pi]; ks_ = SIN[pos * 32 + pi]; } }
#pragma unroll
          for (int tt = 0; tt < 2; ++tt) { const size_t m = (size_t)m0 + wv * 2 + tt; float a[8]; float ss = 0.f, s2 = 0.f;
              unpack8(cq_[tt], a);
#pragma unroll
              for (int i = 0; i < 8; ++i) ss += a[i] * a[i];
              unpack8(ck_[tt], a);
#pragma unroll
              for (int i = 0; i < 8; ++i) s2 += (lane < 32) ? a[i] * a[i] : 0.f;
              ss = wsum(ss); s2 = wsum(s2);
              if (lane == 0) { RSQ[m] = rsqrtf(ss * (1.0f / 512.0f) + LN_EPS_F); RSKV[m] = rsqrtf(s2 * (1.0f / 256.0f) + LN_EPS_F); } }
          { const int tok = tid >> 5, pi = tid & 31; const size_t m = (size_t)m0 + tok; const float x1 = __uint_as_float(kw_ << 16), x2 = __uint_as_float(kw_ & 0xffff0000u);
            *(unsigned*)(KR + m * 64 + 2 * pi) = cvt_pk_bf16(x1 * kc_ - x2 * ks_, x1 * ks_ + x2 * kc_); }
#pragma unroll 1
          for (int jh = 0; jh < 2; ++jh) {
#pragma unroll
            for (int j = 0; j < 4; ++j) { const int item = tid + NTHR * (jh * 4 + j), tok = item >> 8, rem = item & 255, isk = rem >> 7, pr = rem & 127, pi = pr & 31; const size_t m = (size_t)m0 + tok;
                rw_[j] = *(const unsigned*)(P + m * NPC + (isk ? PC_RK : PC_RQ) + 2 * pr); rc_[j] = 1.f; rs_[j] = 0.f;
                if (!isctx) { const int pos = t0 + tok - LC; rc_[j] = COS[pos * 32 + pi]; rs_[j] = SIN[pos * 32 + pi]; } }
#pragma unroll
            for (int j = 0; j < 4; ++j) { const int item = tid + NTHR * (jh * 4 + j), tok = item >> 8, rem = item & 255, isk = rem >> 7, pr = rem & 127; const size_t m = (size_t)m0 + tok;
                const float x1 = __uint_as_float(rw_[j] << 16), x2 = __uint_as_float(rw_[j] & 0xffff0000u), sc_ = isk ? 0.125f : 1.0f;
                *(unsigned*)((isk ? RK : RQ) + m * 256 + 2 * pr) = cvt_pk_bf16((x1 * rc_[j] - x2 * rs_[j]) * sc_, (x1 * rs_[j] + x2 * rc_[j]) * sc_); } } }
        __syncthreads();
        if (tid < 448) { const int tok = tid / 28, c8 = tid % 28; float a[8], bl[8], br[8], o[8];
            unpack8(*(const LAS bf16x8*)(RAW + (tok + 1) * RW_P + 1536 + c8 * 8), a); unpack8(*(const LAS bf16x8*)(RAW + tok * RW_P + 1536 + c8 * 8), bl); unpack8(*(const LAS bf16x8*)(RAW + (tok + 2) * RW_P + 1536 + c8 * 8), br);
#pragma unroll
            for (int i = 0; i < 8; ++i) { const float s = a[i] + (0.5f * (bl[i] + br[i]) - a[i]) * mu[1536 + c8 * 8 + i];
                o[i] = (c8 < 8) ? (1.0f - 2.0f * __builtin_amdgcn_rcpf(1.0f + __expf(2.0f * s))) : ((c8 < 16) ? s : sigmoidf_(s)); }
            const bf16x8 pk = pack8(o);
            if (c8 < 8) { const int jj = c8 * 8; *(LAS bf16x8*)(ACTW + ((jj >> 5) * 16 + tok) * 32 + (jj & 31)) = pk; }
            else if (c8 < 16) { const int jj = (c8 - 8) * 8; *(LAS bf16x8*)(ACTA + ((jj >> 5) * 16 + tok) * 32 + (jj & 31)) = pk; }
            else { const int jj = (c8 - 16) * 8; *(LAS bf16x8*)(ACTG + tok * 96 + jj) = pk; }
        }
        __syncthreads();
        if (MODE == 2) continue;
        {
            const int h = wv, tok = lane & 15, g = lane >> 4; const size_t m = (size_t)m0 + tok;
            const int cb = h * 64 + 16 * g;
            const int wrow = h * 64 + 16 * ((lane & 15) >> 2) + (lane & 3);
            bf16_t* ops = OPS + (m * 8 + h) * OPS_HW + 16 * g;
            float* opw = (float*)(OPS + (m * 8 + h) * OPS_HW) + 16 * g;
#define PREP_SH16(dst, col) do { float c_[16], l_[16], r_[16]; \
                unpack8(*(const LAS bf16x8*)(RAW + (tok + 1) * RW_P + (col)), *(float(*)[8])&c_[0]); unpack8(*(const LAS bf16x8*)(RAW + (tok + 1) * RW_P + (col) + 8), *(float(*)[8])&c_[8]); \
                unpack8(*(const LAS bf16x8*)(RAW + tok * RW_P + (col)), *(float(*)[8])&l_[0]); unpack8(*(const LAS bf16x8*)(RAW + tok * RW_P + (col) + 8), *(float(*)[8])&l_[8]); \
                unpack8(*(const LAS bf16x8*)(RAW + (tok + 2) * RW_P + (col)), *(float(*)[8])&r_[0]); unpack8(*(const LAS bf16x8*)(RAW + (tok + 2) * RW_P + (col) + 8), *(float(*)[8])&r_[8]); \
                _Pragma("unroll") for (int i4 = 0; i4 < 4; ++i4) { const f32x4 m_ = *(const f32x4*)(mu + (col) + 4 * i4); \
                    _Pragma("unroll") for (int i = 0; i < 4; ++i) { const int ii = 4 * i4 + i; dst[ii] = c_[ii] + (0.5f * (l_[ii] + r_[ii]) - c_[ii]) * m_[i]; } } } while (0)
#define PREP_ST16(ptr, v) do { *(bf16x8*)(ptr) = pack8(*(const float(*)[8])&(v)[0]); *(bf16x8*)((ptr) + 8) = pack8(*(const float(*)[8])&(v)[8]); } while (0)
#define PREP_LD16(dst, src) do { _Pragma("unroll") for (int i4 = 0; i4 < 4; ++i4) { const f32x4 t_ = *(const f32x4*)((src) + 4 * i4); dst[4 * i4] = t_[0]; dst[4 * i4 + 1] = t_[1]; dst[4 * i4 + 2] = t_[2]; dst[4 * i4 + 3] = t_[3]; } } while (0)
            const f32x4 z4 = {0.f, 0.f, 0.f, 0.f};
            { const bf16x8 bw0 = *(const LAS bf16x8*)(ACTW + (0 * 16 + tok) * 32 + 8 * g), bw1 = *(const LAS bf16x8*)(ACTW + (1 * 16 + tok) * 32 + 8 * g);
              float zf[16], zb[16], w0f[16], w0b[16]; PREP_LD16(w0f, w0 + cb); PREP_LD16(w0b, w0 + 512 + cb);
#pragma unroll
              for (int ct = 0; ct < 4; ++ct) {
                  const f32x4 a = __builtin_amdgcn_mfma_f32_16x16x32_bf16(*(const bf16x8*)(WUP + ((size_t)0 * 512 + wrow + 4 * ct) * 32 + 8 * g), bw0, z4, 0, 0, 0);
                  const f32x4 c = __builtin_amdgcn_mfma_f32_16x16x32_bf16(*(const bf16x8*)(WUP + ((size_t)1 * 512 + wrow + 4 * ct) * 32 + 8 * g), bw1, z4, 0, 0, 0);
#pragma unroll
                  for (int i = 0; i < 4; ++i) { zf[4 * ct + i] = a[i] + w0f[4 * ct + i]; zb[4 * ct + i] = c[i] + w0b[4 * ct + i]; } }
#pragma unroll
              for (int i = 0; i < 16; ++i) { zf[i] = __expf(-0.6065306597126334f * sigmoidf_(zf[i])); zb[i] = __expf(-0.6065306597126334f * sigmoidf_(zb[i])); }
              if (MODE == 0) {
#pragma unroll
                  for (int i4 = 0; i4 < 4; ++i4) { *(f32x4*)(opw + 4 * i4) = (f32x4){zf[4 * i4], zf[4 * i4 + 1], zf[4 * i4 + 2], zf[4 * i4 + 3]};
                                                   *(f32x4*)(opw + 128 + 4 * i4) = (f32x4){zb[4 * i4], zb[4 * i4 + 1], zb[4 * i4 + 2], zb[4 * i4 + 3]}; } }
              else asm volatile("" :: "v"(zf[0]), "v"(zb[0])); }
            float bon = 0.f;
            { const bf16x8 ba0 = *(const LAS bf16x8*)(ACTA + (0 * 16 + tok) * 32 + 8 * g), ba1 = *(const LAS bf16x8*)(ACTA + (1 * 16 + tok) * 32 + 8 * g);
              float af[16], ab[16]; PREP_LD16(af, a0 + cb); PREP_LD16(ab, a0 + 512 + cb);
#pragma unroll
              for (int ct = 0; ct < 4; ++ct) {
                  const f32x4 a = __builtin_amdgcn_mfma_f32_16x16x32_bf16(*(const bf16x8*)(AUP + ((size_t)0 * 512 + wrow + 4 * ct) * 32 + 8 * g), ba0, z4, 0, 0, 0);
                  const f32x4 c = __builtin_amdgcn_mfma_f32_16x16x32_bf16(*(const bf16x8*)(AUP + ((size_t)1 * 512 + wrow + 4 * ct) * 32 + 8 * g), ba1, z4, 0, 0, 0);
#pragma unroll
                  for (int i = 0; i < 4; ++i) { af[4 * ct + i] = sigmoidf_(af[4 * ct + i] + a[i]); ab[4 * ct + i] = sigmoidf_(ab[4 * ct + i] + c[i]); } }
              float kv[16]; PREP_SH16(kv, 512 + cb);
              float rr[16]; PREP_SH16(rr, cb);
              if (MODE == 0) PREP_ST16(ops + 576, rr); else asm volatile("" :: "v"(rr[0]));
              float ss = 0.f;
#pragma unroll
              for (int i4 = 0; i4 < 4; ++i4) { const f32x4 kk4 = *(const f32x4*)(kkp + cb + 4 * i4);
#pragma unroll
                  for (int i = 0; i < 4; ++i) { const float t = kv[4 * i4 + i] * kk4[i]; ss += t * t; } }
              ss = rows4_sum(ss); const float inv = rsqrtf(ss + 1e-12f);
              unsigned pf[16], pb[16], pnk[8];
#pragma unroll
              for (int i4 = 0; i4 < 4; ++i4) { const f32x4 kk4 = *(const f32x4*)(kkp + cb + 4 * i4), ka4 = *(const f32x4*)(kap + cb + 4 * i4), rk4 = *(const f32x4*)(rkp + cb + 4 * i4);
                  float vnk[4];
#pragma unroll
                  for (int i = 0; i < 4; ++i) { const int ii = 4 * i4 + i; const float kk = kv[ii] * kk4[i] * inv;
                      const float kf = kv[ii] * (1.0f + (af[ii] - 1.0f) * ka4[i]), kb = kv[ii] * (1.0f + (ab[ii] - 1.0f) * ka4[i]);
                      pf[ii] = cvt_pk_bf16(kk * af[ii], kf); pb[ii] = cvt_pk_bf16(kk * ab[ii], kb); vnk[i] = -kk;
                      bon += rr[ii] * (kf + kb) * rk4[i]; }
                  pnk[2 * i4] = cvt_pk_bf16(vnk[0], vnk[1]); pnk[2 * i4 + 1] = cvt_pk_bf16(vnk[2], vnk[3]); }
              if (MODE == 0) { bf16_t* opk = OPS + (m * 8 + h) * OPS_HW + 128 + 32 * g;
#pragma unroll
                  for (int i4 = 0; i4 < 4; ++i4) { *(u32x4*)(opk + 8 * i4) = (u32x4){pf[4 * i4], pf[4 * i4 + 1], pf[4 * i4 + 2], pf[4 * i4 + 3]};
                                                   *(u32x4*)(opk + 256 + 8 * i4) = (u32x4){pb[4 * i4], pb[4 * i4 + 1], pb[4 * i4 + 2], pb[4 * i4 + 3]}; }
                  *(u32x4*)(ops + 512) = (u32x4){pnk[0], pnk[1], pnk[2], pnk[3]}; *(u32x4*)(ops + 520) = (u32x4){pnk[4], pnk[5], pnk[6], pnk[7]}; }
              else asm volatile("" :: "v"(pf[0]), "v"(pb[0]), "v"(pnk[0])); }
            { float vv[16]; PREP_SH16(vv, 1024 + cb);
              if (MODE == 0) { PREP_ST16(ops + 640, vv); PREP_ST16(VSH + m * 512 + cb, vv); } else asm volatile("" :: "v"(vv[0]));
              const bf16x8 bg0 = *(const LAS bf16x8*)(ACTG + tok * 96 + 8 * g), bg1 = *(const LAS bf16x8*)(ACTG + tok * 96 + 32 + 8 * g), bg2 = *(const LAS bf16x8*)(ACTG + tok * 96 + 64 + 8 * g);
              float gg[16];
#pragma unroll
              for (int ct = 0; ct < 4; ++ct) { const bf16_t* gr = GUP + (size_t)(wrow + 4 * ct) * 96 + 8 * g;
                  f32x4 a = __builtin_amdgcn_mfma_f32_16x16x32_bf16(*(const bf16x8*)(gr), bg0, z4, 0, 0, 0);
                  a = __builtin_amdgcn_mfma_f32_16x16x32_bf16(*(const bf16x8*)(gr + 32), bg1, a, 0, 0, 0);
                  a = __builtin_amdgcn_mfma_f32_16x16x32_bf16(*(const bf16x8*)(gr + 64), bg2, a, 0, 0, 0);
#pragma unroll
                  for (int i = 0; i < 4; ++i) gg[4 * ct + i] = a[i]; }
              if (MODE == 0) PREP_ST16(Gb + m * 512 + cb, gg); else asm volatile("" :: "v"(gg[0])); }
            bon = rows4_sum(bon);
            if (g == 0) BON[m * 8 + h] = bon;
#undef PREP_SH16
#undef PREP_ST16
#undef PREP_LD16
        }
    }
    __syncthreads();
}
constexpr int SC_CH = 32;
constexpr int SC_STEP_F = 384;
constexpr int SC_BUF_B = SC_CH * SC_STEP_F * 4;
constexpr int SC_Y_OFF = 2 * SC_BUF_B;

__device__ __forceinline__ int scan_row(int b, int sg, int dir) {
    const int t = dir ? (sg < LC ? (LC - 1 - sg) : (LC + LL - 1 - (sg - LC))) : sg;
    return b * LT + t;
}

template <int MODE>
__device__ __forceinline__ void scan_phase(const Params& p, LAS unsigned char* lds, int bid, int G) {
    const int tid = tid_(), lane = tid & 63, wv = __builtin_amdgcn_readfirstlane(tid >> 6);
    const bf16_t* OPS = (const bf16_t*)(p.ws + WS_OPS);
    constexpr int NCH = LT / SC_CH;
    for (int unit = bid; unit < NB * 8 * 2; unit += G) {
        const int dir = unit & 1, h = (unit >> 1) & 7, b = unit >> 4;
        bf16_t* Yo = (bf16_t*)(p.ws + (dir ? WS_YB : WS_YF));
        __syncthreads();
        const int lt = tid - 256;
#define SC_LOAD_CHUNK(c_) do {   \
            LAS float* buf_ = (LAS float*)(lds + ((c_) & 1) * SC_BUF_B); \
            _Pragma("unroll") for (int j = 0; j < 7; ++j) { const int idx = lt + 256 * j, s = idx / 56, pc = idx % 56; \
                const int m = scan_row(b, (c_) * SC_CH + s, dir); \
                const int src = pc < 16 ? dir * 256 + pc * 8 : (pc < 32 ? dir * 256 + 128 + (pc - 16) * 8 : 256 + pc * 8); \
                const bf16x8 raw = *(const bf16x8*)(OPS + ((size_t)m * 8 + h) * OPS_HW + src); \
                LAS float* d = buf_ + s * SC_STEP_F + (pc < 16 ? pc * 4 : 64 + (pc - 16) * 8); \
                if (pc < 16) { *(LAS bf16x8*)d = raw; } else { float f[8]; unpack8(raw, f); \
                    ((LAS f32x4*)d)[0] = (f32x4){f[0], f[1], f[2], f[3]}; ((LAS f32x4*)d)[1] = (f32x4){f[4], f[5], f[6], f[7]}; } } } while (0)
#define SC_FLUSH_Y(c_) do {   \
            const LAS float* yb_ = (const LAS float*)(lds + SC_Y_OFF + ((c_) & 1) * (SC_CH * 64 * 4)); \
            _Pragma("unroll") for (int j = 0; j < 2; ++j) { const int idx = lt + 256 * j, s = idx >> 4, c4 = (idx & 15) * 4; const int m = scan_row(b, (c_) * SC_CH + s, dir); \
                store_bf4(Yo + (size_t)m * 512 + h * 64 + c4, *(const LAS f32x4*)(yb_ + s * 64 + c4)); } } while (0)
        if (wv >= 4 && MODE != 2) SC_LOAD_CHUNK(0);
        f32x2 Sa[4], Sb[4];
#pragma unroll
        for (int i = 0; i < 4; ++i) { Sa[i] = (f32x2){0.f, 0.f}; Sb[i] = (f32x2){0.f, 0.f}; }
        const int q = lane & 7, il = lane >> 3, row = wv * 16 + 2 * il;
        for (int c = 0; c < NCH; ++c) {
            __syncthreads();
            if (wv >= 4) {
                if (c + 1 < NCH && MODE != 2) SC_LOAD_CHUNK(c + 1);
                if (c >= 1 && MODE == 0) SC_FLUSH_Y(c - 1);
            } else if (MODE != 1) {
                const LAS float* buf = (const LAS float*)(lds + (c & 1) * SC_BUF_B) + 8 * q;
                LAS float* yb = (LAS float*)(lds + SC_Y_OFF + (c & 1) * (SC_CH * 64 * 4));
#define SC_LD(X, s_) const LAS float* sp##X = buf + (s_) * SC_STEP_F; \
                    const f32x4 w0##X = *(const LAS f32x4*)(sp##X), w1##X = *(const LAS f32x4*)(sp##X + 4), b0##X = *(const LAS f32x4*)(sp##X + 64), b1##X = *(const LAS f32x4*)(sp##X + 68), \
                                k0##X = *(const LAS f32x4*)(sp##X + 128), k1##X = *(const LAS f32x4*)(sp##X + 132), n0##X = *(const LAS f32x4*)(sp##X + 192), n1##X = *(const LAS f32x4*)(sp##X + 196), \
                                r0##X = *(const LAS f32x4*)(sp##X + 256), r1##X = *(const LAS f32x4*)(sp##X + 260); \
                    const f32x2 vv##X = *(const LAS f32x2*)(sp##X - 8 * q + 320 + row);
#define LO2(v) __builtin_shufflevector(v, v, 0, 1)
#define HI2(v) __builtin_shufflevector(v, v, 2, 3)
#define SC_STEP(X, s_) { \
                    const f32x2 vA = {vv##X[0], vv##X[0]}, vB = {vv##X[1], vv##X[1]}; \
                      \
                    const f32x2 da = (Sa[0] * LO2(n0##X) + Sa[1] * HI2(n0##X)) + (Sa[2] * LO2(n1##X) + Sa[3] * HI2(n1##X)); \
                    const f32x2 db = (Sb[0] * LO2(n0##X) + Sb[1] * HI2(n0##X)) + (Sb[2] * LO2(n1##X) + Sb[3] * HI2(n1##X)); \
                    f32x2 sa = {da[0] + da[1], db[0] + db[1]}; \
                      \
                    const f32x2 pa0 = Sa[0] * LO2(w0##X) + vA * LO2(k0##X), pa1 = Sa[1] * HI2(w0##X) + vA * HI2(k0##X), pa2 = Sa[2] * LO2(w1##X) + vA * LO2(k1##X), pa3 = Sa[3] * HI2(w1##X) + vA * HI2(k1##X); \
                    const f32x2 pb0 = Sb[0] * LO2(w0##X) + vB * LO2(k0##X), pb1 = Sb[1] * HI2(w0##X) + vB * HI2(k0##X), pb2 = Sb[2] * LO2(w1##X) + vB * LO2(k1##X), pb3 = Sb[3] * HI2(w1##X) + vB * HI2(k1##X); \
                    sa = red8x2(sa); \
                    const f32x2 saA = {sa[0], sa[0]}, saB = {sa[1], sa[1]}; \
                    Sa[0] = pa0 + saA * LO2(b0##X); Sa[1] = pa1 + saA * HI2(b0##X); Sa[2] = pa2 + saA * LO2(b1##X); Sa[3] = pa3 + saA * HI2(b1##X); \
                    Sb[0] = pb0 + saB * LO2(b0##X); Sb[1] = pb1 + saB * HI2(b0##X); Sb[2] = pb2 + saB * LO2(b1##X); Sb[3] = pb3 + saB * HI2(b1##X); \
                    const f32x2 ya = (Sa[0] * LO2(r0##X) + Sa[1] * HI2(r0##X)) + (Sa[2] * LO2(r1##X) + Sa[3] * HI2(r1##X)); \
                    const f32x2 yb2 = (Sb[0] * LO2(r0##X) + Sb[1] * HI2(r0##X)) + (Sb[2] * LO2(r1##X) + Sb[3] * HI2(r1##X)); \
                    f32x2 yy = {ya[0] + ya[1], yb2[0] + yb2[1]}; yy = red8x2(yy); \
                    if (q == 0) *(LAS f32x2*)(yb + (s_) * 64 + row) = yy; }
#pragma unroll 1
                for (int s = 0; s < SC_CH; s += 4) {
                    SC_LD(A, s) SC_LD(B, s + 1)
                    SC_STEP(A, s)
                    SC_LD(C, s + 2)
                    SC_STEP(B, s + 1)
                    SC_LD(D, s + 3)
                    SC_STEP(C, s + 2)
                    SC_STEP(D, s + 3)
                }
#undef LO2
#undef HI2
#undef SC_LD
#undef SC_STEP
            }
        }
        __syncthreads();
        if (wv >= 4 && MODE == 0) SC_FLUSH_Y(NCH - 1);
    }
    __syncthreads();
#undef SC_LOAD_CHUNK
#undef SC_FLUSH_Y
}
constexpr int RT_PQ = 72, RT_PT = 136;
constexpr int RT_QS = 0, RT_KS = RT_QS + 128 * RT_PQ * 2, RT_KDT = RT_KS + 128 * RT_PQ * 2, RT_VT = RT_KDT + 64 * RT_PT * 2,
              RT_PS = RT_VT + 64 * RT_PT * 2, RT_RT = RT_PS + 128 * RT_PT * 2, RT_END = RT_RT + 64 * RT_PQ * 2;
static_assert(RT_END <= 131072, "retention LDS");
__device__ __forceinline__ int crow32(int r, int hi) { return (r & 3) + 8 * (r >> 2) + 4 * hi; }

__device__ __forceinline__ void ret_phase(const Params& p, LAS unsigned char* lds, int bid, int G) {
    const int tid = tid_(), lane = tid & 63, wv = __builtin_amdgcn_readfirstlane(tid >> 6), l31 = lane & 31, hi = lane >> 5;
    LAS bf16_t* Qs = (LAS bf16_t*)(lds + RT_QS); LAS bf16_t* Ks = (LAS bf16_t*)(lds + RT_KS); LAS bf16_t* KdT = (LAS bf16_t*)(lds + RT_KDT);
    LAS bf16_t* VT = (LAS bf16_t*)(lds + RT_VT); LAS bf16_t* Ps = (LAS bf16_t*)(lds + RT_PS); LAS bf16_t* RTt = (LAS bf16_t*)(lds + RT_RT);
    const bf16_t* P = (const bf16_t*)(p.ws + WS_P); const bf16_t* RQ = (const bf16_t*)(p.ws + WS_RQ); const bf16_t* RK = (const bf16_t*)(p.ws + WS_RK);
    for (int unit = bid; unit < NB * 4 * 2 * 2; unit += G) {
        const int vh = unit & 1, dir = (unit >> 1) & 1, h = (unit >> 2) & 3, b = unit >> 4;
        bf16_t* Oo = (bf16_t*)(p.ws + (dir ? WS_OB : WS_OF));
        const float lg2 = log2f(1.0f - exp2f(-5.0f - (float)h - 0.5f * (float)dir));
        const float cdec = exp2f(lg2 * 128.0f);
        f32x16 Racc;
#pragma unroll
        for (int r = 0; r < 16; ++r) Racc[r] = 0.f;
        __syncthreads();
        for (int i = tid; i < 64 * RT_PQ / 2; i += NTHR) ((LAS unsigned*)RTt)[i] = 0u;
        for (int ci = 0; ci < 18; ++ci) {
            const int tc0 = dir ? (ci < 2 ? (1 - ci) * 128 : LC + (17 - ci) * 128) : ci * 128;
            const size_t mc0 = (size_t)b * LT + tc0;
            __syncthreads();
#pragma unroll 1
            for (int j = 0; j < 2; ++j) { const int item = tid + NTHR * j, tok = item >> 3, c8 = item & 7; const size_t m = mc0 + tok;
                const bf16x8 qv = *(const bf16x8*)(RQ + m * 256 + h * 64 + c8 * 8), kv = *(const bf16x8*)(RK + m * 256 + h * 64 + c8 * 8);
                const bf16x8 vv = *(const bf16x8*)(P + m * NPC + PC_RV + h * 128 + vh * 64 + c8 * 8);
                *(LAS bf16x8*)(Qs + tok * RT_PQ + c8 * 8) = qv; *(LAS bf16x8*)(Ks + tok * RT_PQ + c8 * 8) = kv;
                const float kd = exp2f(lg2 * (float)(dir ? tok : 127 - tok));
#pragma unroll
                for (int i = 0; i < 8; ++i) { KdT[(c8 * 8 + i) * RT_PT + tok] = f2bf(bf2f((bf16_t)kv[i]) * kd); VT[(c8 * 8 + i) * RT_PT + tok] = (bf16_t)vv[i]; } }
            __syncthreads();
#pragma unroll 1
            for (int tt = 0; tt < 2; ++tt) { const int tile = wv * 2 + tt, qt = tile >> 2, kt = tile & 3;
                const bool live = dir ? (kt >= qt) : (kt <= qt);
                f32x16 s;
#pragma unroll
                for (int r = 0; r < 16; ++r) s[r] = 0.f;
                if (live) {
#pragma unroll
                    for (int ks = 0; ks < 4; ++ks) { const bf16x8 a = *(const LAS bf16x8*)(Qs + (qt * 32 + l31) * RT_PQ + ks * 16 + hi * 8), bb = *(const LAS bf16x8*)(Ks + (kt * 32 + l31) * RT_PQ + ks * 16 + hi * 8);
                        s = __builtin_amdgcn_mfma_f32_32x32x16_bf16(a, bb, s, 0, 0, 0); }
                }
                const int key = kt * 32 + l31;
#pragma unroll
                for (int r = 0; r < 16; ++r) { const int qq = qt * 32 + crow32(r, hi); const int d = dir ? (key - qq) : (qq - key);
                    const float v = (live && d >= 0) ? s[r] * exp2f(lg2 * (float)d) : 0.f;
                    Ps[qq * RT_PT + key] = f2bf(v); }
            }
            __syncthreads();
            { const int qt = wv >> 1, vt = wv & 1; f32x16 o;
#pragma unroll
                for (int r = 0; r < 16; ++r) o[r] = 0.f;
#pragma unroll
                for (int ks = 0; ks < 4; ++ks) { const bf16x8 a = *(const LAS bf16x8*)(Qs + (qt * 32 + l31) * RT_PQ + ks * 16 + hi * 8), bb = *(const LAS bf16x8*)(RTt + (vt * 32 + l31) * RT_PQ + ks * 16 + hi * 8);
                    o = __builtin_amdgcn_mfma_f32_32x32x16_bf16(a, bb, o, 0, 0, 0); }
#pragma unroll
                for (int r = 0; r < 16; ++r) { const int pos = qt * 32 + crow32(r, hi); o[r] *= exp2f(lg2 * (float)(dir ? 128 - pos : pos + 1)); }
#pragma unroll
                for (int ks = 0; ks < 8; ++ks) { const bf16x8 a = *(const LAS bf16x8*)(Ps + (qt * 32 + l31) * RT_PT + ks * 16 + hi * 8), bb = *(const LAS bf16x8*)(VT + (vt * 32 + l31) * RT_PT + ks * 16 + hi * 8);
                    o = __builtin_amdgcn_mfma_f32_32x32x16_bf16(a, bb, o, 0, 0, 0); }
#pragma unroll
                for (int r = 0; r < 16; ++r) Oo[(mc0 + qt * 32 + crow32(r, hi)) * 512 + h * 128 + vh * 64 + vt * 32 + l31] = f2bf(o[r]);
            }
            if (wv < 4) { const int dkt = wv >> 1, vt = wv & 1;
#pragma unroll
                for (int r = 0; r < 16; ++r) Racc[r] *= cdec;
#pragma unroll
                for (int ks = 0; ks < 8; ++ks) { const bf16x8 a = *(const LAS bf16x8*)(KdT + (dkt * 32 + l31) * RT_PT + ks * 16 + hi * 8), bb = *(const LAS bf16x8*)(VT + (vt * 32 + l31) * RT_PT + ks * 16 + hi * 8);
                    Racc = __builtin_amdgcn_mfma_f32_32x32x16_bf16(a, bb, Racc, 0, 0, 0); }
            }
            __syncthreads();
            if (wv < 4) { const int dkt = wv >> 1, vt = wv & 1;
#pragma unroll
                for (int r = 0; r < 16; ++r) RTt[(vt * 32 + l31) * RT_PQ + dkt * 32 + crow32(r, hi)] = f2bf(Racc[r]); }
        }
    }
    __syncthreads();
}
namespace att {
constexpr int QBLK = 32, KVBLK = 64;
constexpr float SCALE = 0.07216878364870322f;
constexpr float THR = 8.f;
constexpr int SHM_T = KVBLK * 128 * 2;
constexpr int OFF_V = 0, OFF_KN = 2 * SHM_T, OFF_KR = 4 * SHM_T, OFF_WS = 6 * SHM_T;
#define KSWZ(row, colB) ((row) * 256 + ((colB) ^ (((row) & 7) << 4)))
#define SBAR() __builtin_amdgcn_sched_barrier(0)
__device__ __forceinline__ int crow(int r, int hi) { return (r & 3) + 8 * (r >> 2) + 4 * hi; }

__device__ __forceinline__ void partialSM(f32x16& p0, f32x16& p1, float& m_reg, float& mn, float& alpha) {
  constexpr float C = SCALE * 1.4426950408889634f;
  float pmax = p0[0];
#pragma unroll
  for (int r = 1; r < 16; ++r) pmax = fmaxf(pmax, p0[r]);
#pragma unroll
  for (int r = 0; r < 16; ++r) pmax = fmaxf(pmax, p1[r]);
  { auto rr = __builtin_amdgcn_permlane32_swap(__float_as_uint(pmax), __float_as_uint(pmax), false, false);
    pmax = fmaxf(__uint_as_float(rr[0]), __uint_as_float(rr[1])); }
  if (__builtin_expect(__all(pmax - m_reg <= THR / SCALE), 1)) { mn = m_reg; alpha = 1.f; }
  else { mn = fmaxf(m_reg, pmax); alpha = __builtin_amdgcn_exp2f((m_reg - mn) * C); m_reg = mn; }
  const float mnC = -mn * C;
#pragma unroll
  for (int r = 0; r < 16; ++r) p0[r] = __builtin_amdgcn_exp2f(fmaf(p0[r], C, mnC));
#pragma unroll
  for (int r = 0; r < 16; ++r) p1[r] = __builtin_amdgcn_exp2f(fmaf(p1[r], C, mnC));
}
__device__ __forceinline__ void finishSM(const f32x16& p0, const f32x16& p1, float alpha, float& l_reg, bf16x8& pa0, bf16x8& pa1, bf16x8& pa2, bf16x8& pa3) {
  float ps = 0;
#pragma unroll
  for (int r = 0; r < 16; ++r) ps += p0[r];
#pragma unroll
  for (int r = 0; r < 16; ++r) ps += p1[r];
  { auto rr = __builtin_amdgcn_permlane32_swap(__float_as_uint(ps), __float_as_uint(ps), false, false);
    ps = __uint_as_float(rr[0]) + __uint_as_float(rr[1]); }
  l_reg = l_reg * alpha + ps;
#define PK4(P, BASE, OUT) do { unsigned a0 = cvt_pk_bf16(P[BASE + 0], P[BASE + 1]), a1 = cvt_pk_bf16(P[BASE + 2], P[BASE + 3]);   \
    unsigned b0 = cvt_pk_bf16(P[BASE + 4], P[BASE + 5]), b1 = cvt_pk_bf16(P[BASE + 6], P[BASE + 7]);                              \
    auto r0 = __builtin_amdgcn_permlane32_swap(a0, b0, false, false); auto r1 = __builtin_amdgcn_permlane32_swap(a1, b1, false, false); \
    u32x4 w = {r0[0], r1[0], r0[1], r1[1]}; OUT = *reinterpret_cast<bf16x8*>(&w); } while (0)
  PK4(p0, 0, pa0); PK4(p0, 8, pa1); PK4(p1, 0, pa2); PK4(p1, 8, pa3);
#undef PK4
}
__device__ __forceinline__ int v_st(int k, int c) { const int kk = (k & ~0xC) | ((k & 4) << 1) | ((k & 8) >> 1); return ((kk >> 3) * 4 + (c >> 5)) * 512 + ((kk & 7) * 32 + (c & 31)) * 2; }
__device__ __forceinline__ int v_rd_base(int lane) { return ((lane & 3) << 3) | (((lane >> 2) & 3) << 6) | (((lane >> 4) & 1) << 5) | (((lane >> 5) & 1) << 8); }
constexpr int v_rd_off(int d0, int ks, int half) { return d0 * 512 + ks * 4096 + half * 2048; }
template <int OFF> __device__ __forceinline__ s16x4 tr_read(int vb) {
  s16x4 r; asm volatile("ds_read_b64_tr_b16 %0, %1 offset:%2" : "=&v"(r) : "v"(vb), "i"(OFF) : "memory"); return r;
}
template <int D0> __device__ __forceinline__ void pv_one(f32x16& od, int vb, bf16x8 pa0, bf16x8 pa1, bf16x8 pa2, bf16x8 pa3) {
  const s16x4 l0 = tr_read<v_rd_off(D0, 0, 0)>(vb), h0 = tr_read<v_rd_off(D0, 0, 1)>(vb), l1 = tr_read<v_rd_off(D0, 1, 0)>(vb), h1 = tr_read<v_rd_off(D0, 1, 1)>(vb);
  const s16x4 l2 = tr_read<v_rd_off(D0, 2, 0)>(vb), h2 = tr_read<v_rd_off(D0, 2, 1)>(vb), l3 = tr_read<v_rd_off(D0, 3, 0)>(vb), h3 = tr_read<v_rd_off(D0, 3, 1)>(vb);
  asm volatile("s_waitcnt lgkmcnt(0)" ::: "memory"); SBAR();
#define PKV(L, H) (bf16x8){L[0], L[1], L[2], L[3], H[0], H[1], H[2], H[3]}
  od = __builtin_amdgcn_mfma_f32_32x32x16_bf16(pa0, PKV(l0, h0), od, 0, 0, 0);
  od = __builtin_amdgcn_mfma_f32_32x32x16_bf16(pa1, PKV(l1, h1), od, 0, 0, 0);
  od = __builtin_amdgcn_mfma_f32_32x32x16_bf16(pa2, PKV(l2, h2), od, 0, 0, 0);
  od = __builtin_amdgcn_mfma_f32_32x32x16_bf16(pa3, PKV(l3, h3), od, 0, 0, 0);
#undef PKV
}

__device__ __forceinline__ void attn_unit(const bf16_t* __restrict__ Qb, int rope_pos0, const bf16_t* __restrict__ Kn, const bf16_t* __restrict__ Vp, const bf16_t* __restrict__ Kr,
                                          bf16_t* __restrict__ Ob, int nkeys, const float* __restrict__ COS, const float* __restrict__ SIN, LAS unsigned char* ldsb) {
  LAS char* lds = (LAS char*)ldsb;
  const int tid = tid_(), wid = tid >> 6, lane = tid & 63, r32 = lane & 31, hi = lane >> 5;
  LAS float* ws = (LAS float*)(lds + OFF_WS) + wid * 64; LAS float* li_l = ws; LAS float* al_l = ws + 32;
  float m_reg = -1e30f, l_reg = 0; f32x16 o[4]; bf16x8 qr[12];
#pragma unroll
  for (int d = 0; d < 4; ++d)
#pragma unroll
    for (int r = 0; r < 16; ++r) o[d][r] = 0.f;
  const bf16_t* Qw = Qb + (size_t)(wid * QBLK + r32) * 1536 + hi * 8;
#pragma unroll
  for (int d0 = 0; d0 < 8; ++d0) qr[d0] = *(const bf16x8*)(Qw + d0 * 16);
#pragma unroll
  for (int d0 = 8; d0 < 12; ++d0) {
    bf16x8 x = *(const bf16x8*)(Qw + 128 + (d0 - 8) * 16);
    if (rope_pos0 >= 0) { const int pos = rope_pos0 + wid * QBLK + r32, pi = (d0 - 8) * 8 + hi * 4;
      const f32x4 c = *(const f32x4*)(COS + pos * 32 + pi), s = *(const f32x4*)(SIN + pos * 32 + pi);
      float f[8]; unpack8(x, f); float g[8];
#pragma unroll
      for (int i = 0; i < 4; ++i) { g[2 * i] = f[2 * i] * c[i] - f[2 * i + 1] * s[i]; g[2 * i + 1] = f[2 * i] * s[i] + f[2 * i + 1] * c[i]; }
      x = pack8(g); }
    qr[d0] = x; }
  const int sr = tid >> 4, sc = (tid & 15) * 8, vst0 = v_st(sr, sc), vst1 = v_st(32 + sr, sc);
  const int kr_r = tid >> 3, kr_c = (tid & 7) * 8;
  const int vb0 = (int)(uintptr_t)(lds + OFF_V) + v_rd_base(lane);
  bf16x8 vs0, vs1, ks0, ks1, krs;
#define SLOAD(k0) do { vs0 = *(const bf16x8*)(Vp + (size_t)((k0) + sr) * 2048 + sc); vs1 = *(const bf16x8*)(Vp + (size_t)((k0) + 32 + sr) * 2048 + sc); \
    ks0 = *(const bf16x8*)(Kn + (size_t)((k0) + sr) * 2048 + sc); ks1 = *(const bf16x8*)(Kn + (size_t)((k0) + 32 + sr) * 2048 + sc); \
    krs = *(const bf16x8*)(Kr + (size_t)((k0) + kr_r) * 64 + kr_c); } while (0)
#define SWRITE(b) do { *(LAS bf16x8*)(lds + OFF_V + (b) * SHM_T + vst0) = vs0; *(LAS bf16x8*)(lds + OFF_V + (b) * SHM_T + vst1) = vs1; \
    *(LAS bf16x8*)(lds + OFF_KN + (b) * SHM_T + KSWZ(sr, sc * 2)) = ks0; *(LAS bf16x8*)(lds + OFF_KN + (b) * SHM_T + KSWZ(32 + sr, sc * 2)) = ks1; \
    *(LAS bf16x8*)(lds + OFF_KR + (b) * SHM_T + KSWZ(kr_r, kr_c * 2)) = krs; } while (0)
  const int NT = nkeys / KVBLK;
  __syncthreads();
  SLOAD(0); SWRITE(0); __syncthreads();
  for (int j = 0; j < NT; ++j) {
    const int bsel = j & 1;
    f32x16 p0, p1;
#pragma unroll
    for (int r = 0; r < 16; ++r) { p0[r] = 0.f; p1[r] = 0.f; }
    { const LAS char* Kn_l = lds + OFF_KN + bsel * SHM_T; const LAS char* Kr_l = lds + OFF_KR + bsel * SHM_T;
#pragma unroll
      for (int d0 = 0; d0 < 8; ++d0) { const int cb = (d0 * 16 + hi * 8) * 2;
        const bf16x8 b0 = *(const LAS bf16x8*)(Kn_l + KSWZ(r32, cb)), b1 = *(const LAS bf16x8*)(Kn_l + KSWZ(32 + r32, cb));
        p0 = __builtin_amdgcn_mfma_f32_32x32x16_bf16(b0, qr[d0], p0, 0, 0, 0); p1 = __builtin_amdgcn_mfma_f32_32x32x16_bf16(b1, qr[d0], p1, 0, 0, 0); }
#pragma unroll
      for (int d0 = 8; d0 < 12; ++d0) { const int cb = ((d0 - 8) * 16 + hi * 8) * 2;
        const bf16x8 b0 = *(const LAS bf16x8*)(Kr_l + KSWZ(r32, cb)), b1 = *(const LAS bf16x8*)(Kr_l + KSWZ(32 + r32, cb));
        p0 = __builtin_amdgcn_mfma_f32_32x32x16_bf16(b0, qr[d0], p0, 0, 0, 0); p1 = __builtin_amdgcn_mfma_f32_32x32x16_bf16(b1, qr[d0], p1, 0, 0, 0); }
    }
    float mn, alpha; partialSM(p0, p1, m_reg, mn, alpha);
    if (j + 1 < NT) SLOAD((j + 1) * KVBLK);
    if (__any(alpha < 1.f)) { if (hi == 0) al_l[r32] = alpha; asm volatile("s_waitcnt lgkmcnt(0)" ::: "memory");
#pragma unroll
      for (int d = 0; d < 4; ++d)
#pragma unroll
        for (int r = 0; r < 16; ++r) o[d][r] *= al_l[crow(r, hi)]; }
    bf16x8 pa0, pa1, pa2, pa3; finishSM(p0, p1, alpha, l_reg, pa0, pa1, pa2, pa3); SBAR();
    { const int vb = vb0 + bsel * SHM_T;
      pv_one<0>(o[0], vb, pa0, pa1, pa2, pa3); pv_one<1>(o[1], vb, pa0, pa1, pa2, pa3); pv_one<2>(o[2], vb, pa0, pa1, pa2, pa3); pv_one<3>(o[3], vb, pa0, pa1, pa2, pa3); }
    if (j + 1 < NT) SWRITE(bsel ^ 1);
    __syncthreads();
  }
  if (hi == 0) li_l[r32] = l_reg; asm volatile("s_waitcnt lgkmcnt(0)" ::: "memory");
  float rli[16];
#pragma unroll
  for (int r = 0; r < 16; ++r) rli[r] = __builtin_amdgcn_rcpf(li_l[crow(r, hi)]);
  bf16_t* Ow = Ob + (size_t)(wid * QBLK) * 2048;
#pragma unroll
  for (int r = 0; r < 16; ++r) { const int orow = crow(r, hi);
#pragma unroll
    for (int d0 = 0; d0 < 4; ++d0) Ow[(size_t)orow * 2048 + d0 * 32 + r32] = f2bf(o[d0][r] * rli[r]); }
#undef SLOAD
#undef SWRITE
}
#undef KSWZ
#undef SBAR
}

__device__ __forceinline__ void attn_phase(const Params& p, LAS unsigned char* lds, int l, int bid, int G) {
    const bf16_t* Q = (const bf16_t*)(p.ws + WS_Q); const bf16_t* KV = (const bf16_t*)(p.ws + WS_KV); const bf16_t* KR = (const bf16_t*)(p.ws + WS_KR);
    bf16_t* MIX = (bf16_t*)(p.ws + WS_MIX);
    const float* COS = (const float*)(p.ws + WS_COS); const float* SIN = (const float*)(p.ws + WS_SIN);
    const int nlat = NB * 8 * 8, nctx = (l < DEPTH - 1) ? NB * 8 : 0;
    const int x = bid & 7, jj = bid >> 3;
    const bool young = __builtin_amdgcn_readfirstlane(tid_()) >= 256;
    if (young) __builtin_amdgcn_s_setprio(1);
    for (int rnd = 0; ; ++rnd) {
        int u;
        if (G == 256) { const int pair = rnd * 32 + x * 4 + (jj >> 3); u = pair * 8 + (jj & 7); if (pair >= NB * 8) u = nlat + (rnd - 4) * 256 + bid; }
        else u = rnd * G + bid;
        if (u >= nlat + nctx) break;
        int b, h, qrow, rpos, nk;
        if (u < nlat) { const int qb = u & 7; h = (u >> 3) & 7; b = u >> 6; qrow = LC + qb * 256; rpos = qb * 256; nk = LT; }
        else { const int v = u - nlat; h = v & 7; b = v >> 3; qrow = 0; rpos = -1; nk = LC; }
        const size_t k0 = (size_t)b * LT, r0 = k0 + qrow;
        att::attn_unit(Q + r0 * 1536 + h * 192, rpos, KV + k0 * 2048 + h * 256, KV + k0 * 2048 + h * 256 + 128, KR + k0 * 64, MIX + r0 * 2048 + 512 + h * 128, nk, COS, SIN, lds);
    }
    __builtin_amdgcn_s_setprio(0);
    __syncthreads();
}
__device__ __forceinline__ void finish_phase(const Params& p, int l, int bid, int G) {
    const int tid = tid_(), lane = tid & 63, wv = tid >> 6;
    const bf16_t* YF = (const bf16_t*)(p.ws + WS_YF); const bf16_t* YB = (const bf16_t*)(p.ws + WS_YB);
    const bf16_t* OF = (const bf16_t*)(p.ws + WS_OF); const bf16_t* OB = (const bf16_t*)(p.ws + WS_OB);
    const bf16_t* VSH = (const bf16_t*)(p.ws + WS_VSH); const bf16_t* Gb = (const bf16_t*)(p.ws + WS_G); const float* BON = (const float*)(p.ws + WS_BON);
    const bf16_t* P = (const bf16_t*)(p.ws + WS_P);
    bf16_t* MIX = (bf16_t*)(p.ws + WS_MIX);
    const float* gng = p.in[I_GNG] + l * 512; const float* gnb = p.in[I_GNB] + l * 512;
    const float* rgg = p.in[I_RGG] + l * 512; const float* rgb = p.in[I_RGB] + l * 512;
    const int c = lane * 8;
    for (int m = bid * 8 + wv; m < MT; m += G * 8) {
        if (l == DEPTH - 1 && (m % LT) < LC) continue;
        {
            const int h = lane >> 3;
            float y[8]; { float ya[8], yb8[8]; unpack8(*(const bf16x8*)(YF + (size_t)m * 512 + c), ya); unpack8(*(const bf16x8*)(YB + (size_t)m * 512 + c), yb8);
#pragma unroll
                          for (int i = 0; i < 8; ++i) y[i] = ya[i] + yb8[i]; }
            float s = 0.f;
#pragma unroll
            for (int i = 0; i < 8; ++i) s += y[i];
            const float mean = red8(s) * (1.0f / 64.0f); float q = 0.f;
#pragma unroll
            for (int i = 0; i < 8; ++i) { y[i] -= mean; q += y[i] * y[i]; }
            const float rstd = rsqrtf(red8(q) * (1.0f / 64.0f) + 64e-5f);
            float vv[8], gg[8]; unpack8(*(const bf16x8*)(VSH + (size_t)m * 512 + c), vv); unpack8(*(const bf16x8*)(Gb + (size_t)m * 512 + c), gg);
            const float bon = BON[(size_t)m * 8 + h];
            float o[8];
#pragma unroll
            for (int i = 0; i < 8; ++i) o[i] = (y[i] * rstd * gng[c + i] + gnb[c + i] + bon * vv[i]) * gg[i];
            *(bf16x8*)(MIX + (size_t)m * DM + c) = pack8(o);
        }
        {
            float y[8]; { float ya[8], yb8[8]; unpack8(*(const bf16x8*)(OF + (size_t)m * 512 + c), ya); unpack8(*(const bf16x8*)(OB + (size_t)m * 512 + c), yb8);
#pragma unroll
                          for (int i = 0; i < 8; ++i) y[i] = ya[i] + yb8[i]; }
            float s = 0.f;
#pragma unroll
            for (int i = 0; i < 8; ++i) s += y[i];
            const float mean = row16_sum(s) * (1.0f / 128.0f); float q = 0.f;
#pragma unroll
            for (int i = 0; i < 8; ++i) { y[i] -= mean; q += y[i] * y[i]; }
            const float rstd = rsqrtf(row16_sum(q) * (1.0f / 128.0f) + 1e-5f);
            float gt[8]; unpack8(*(const bf16x8*)(P + (size_t)m * NPC + PC_RG + c), gt);
            float o[8];
#pragma unroll
            for (int i = 0; i < 8; ++i) o[i] = (y[i] * rstd * rgg[c + i] + rgb[c + i]) * siluf_(gt[i]);
            *(bf16x8*)(MIX + (size_t)m * DM + 1536 + c) = pack8(o);
        }
    }
}
namespace co {
constexpr int TS = 8, NTS = LT / TS;
constexpr int A_V = 0, A_KN = 32768, A_KR = 65536, A_WS = 81920;
constexpr int CO_STEP_B = 896;
constexpr int CO_BK = 256, CO_R = 512, CO_N = 640, CO_V = 768;
constexpr int S_SBB = TS * CO_STEP_B, S_SB = 83968, S_YB = TS * 64 * 4, S_Y = S_SB + 2 * S_SBB;
static_assert(S_Y + 3 * S_YB <= 131072, "co-run LDS");
#define CO_BAR() do { asm volatile("s_waitcnt vmcnt(0) lgkmcnt(0)" ::: "memory"); __builtin_amdgcn_s_barrier(); asm volatile("" ::: "memory"); } while (0)
#define CO_BAR_S() do { asm volatile("s_waitcnt lgkmcnt(0)" ::: "memory"); __builtin_amdgcn_s_barrier(); asm volatile("" ::: "memory"); } while (0)

template <int NOLD, int ROLE>
__device__ __forceinline__ void scan_role(const Params& p, LAS unsigned char* ldsb, int unit, int T) {
    LAS char* lds = (LAS char*)ldsb;
    const int tid = tid_() - (ROLE == 2 ? 256 : 0), lane = tid & 63, wv = __builtin_amdgcn_readfirstlane(tid >> 6);
    const int dir = unit & 1, h = (unit >> 1) & 7, b = unit >> 4;
    const bf16_t* OPS = (const bf16_t*)(p.ws + WS_OPS); bf16_t* Yo = (bf16_t*)(p.ws + (dir ? WS_YB : WS_YF));
    const int n = lane & 15, j = lane >> 4;
    const int sA = tid / 56, pA = tid % 56; const int iB = 256 + (tid < 192 ? tid : 0), sB = iB / 56, pB = iB % 56; const bool hasB = tid < 192;
#define CO_SRC(pc_) ((pc_) < 32 ? dir * 256 + (pc_) * 8 : 256 + (pc_) * 8)
#define CO_DST(pc_) ((pc_) < 16 ? (pc_) * 16 : ((pc_) < 32 ? CO_BK + 64 * ((((pc_) - 16) >> 1) & 3) + 4 * (2 * (((pc_) - 16) >> 3) + ((pc_) & 1)) : ((pc_) < 40 ? CO_N + ((pc_) - 32) * 16 : ((pc_) < 48 ? CO_R + ((pc_) - 40) * 16 : CO_V + ((pc_) - 48) * 16))))
    const int srcA = CO_SRC(pA), dstA = CO_DST(pA), srcB = CO_SRC(pB), dstB = CO_DST(pB); const int shA = (pA >= 40 && pA < 48) ? 1 : 0, shB = (pB >= 40 && pB < 48) ? 1 : 0;
    const bool bkA = pA >= 16 && pA < 32, bkB = pB >= 16 && pB < 32;
#define CO_G(k_, s_, sh_) ({ int g_ = (k_) * TS + (s_) - (sh_); g_ = g_ < 0 ? 0 : (g_ > LT - 1 ? LT - 1 : g_); g_; })
#define CO_LDOP(k_, s_, src_, sh_) (*(const bf16x8*)(OPS + ((size_t)scan_row(b, CO_G(k_, s_, sh_), dir) * 8 + h) * OPS_HW + (src_)))
#define CO_WROP(reg_, k_, s_, dst_, isbk_) do { LAS char* d_ = lds + S_SB + ((k_) & 1) * S_SBB + (s_) * CO_STEP_B + (dst_); \
        if (isbk_) { const u32x4 r_ = __builtin_bit_cast(u32x4, reg_); *(LAS unsigned*)d_ = r_[0]; *(LAS unsigned*)(d_ + 16) = r_[1]; *(LAS unsigned*)(d_ + 32) = r_[2]; *(LAS unsigned*)(d_ + 48) = r_[3]; } \
        else *(LAS bf16x8*)d_ = reg_; } while (0)
    bf16x8 ra, rb, rc, rd;
#pragma unroll
    for (int i = 0; i < 8; ++i) { ra[i] = 0; rb[i] = 0; rc[i] = 0; rd[i] = 0; }
    if (ROLE != 1) {
        ra = CO_LDOP(0, sA, srcA, shA); rb = ra; if (hasB) rb = CO_LDOP(0, sB, srcB, shB);
        CO_WROP(ra, 0, sA, dstA, bkA); if (hasB) CO_WROP(rb, 0, sB, dstB, bkB);
        ra = CO_LDOP(1, sA, srcA, shA); if (hasB) rb = CO_LDOP(1, sB, srcB, shB);
        if (ROLE == 2) { rc = CO_LDOP(2, sA, srcA, shA); rd = rc; if (hasB) rd = CO_LDOP(2, sB, srcB, shB); }
    }
    f32x4 T0 = {0.f, 0.f, 0.f, 0.f}, T1 = T0, T2 = T0, T3 = T0; bf16x8 Tb0, Tb1;
#pragma unroll
    for (int i = 0; i < 8; ++i) { Tb0[i] = 0; Tb1[i] = 0; }
    const f32x4 z4 = {0.f, 0.f, 0.f, 0.f};
    const int o_dot = (n == 0 ? CO_R : CO_N) + 16 * j;
    const int o_w = 32 * j;
    const int o_bk = CO_BK + 16 * n;
    const int o_v = CO_V + 2 * (wv * 16 + n);
    LAS float* yr = (LAS float*)(lds + S_Y) + wv * 16 + n;
    CO_BAR_S();
    if (ROLE == 1) __builtin_amdgcn_s_setprio(2);
#define SC_LD(X, s_) const LAS char* sp##X = buf + (s_) * CO_STEP_B; \
        const bf16x8 a0##X = *(const LAS bf16x8*)(sp##X + o_dot), a1##X = *(const LAS bf16x8*)(sp##X + o_dot + 64); \
        const f32x4 w0##X = *(const LAS f32x4*)(sp##X + o_w), w1##X = *(const LAS f32x4*)(sp##X + o_w + 16), w2##X = *(const LAS f32x4*)(sp##X + o_w + 128), w3##X = *(const LAS f32x4*)(sp##X + o_w + 144); \
        const bf16x8 bk##X = *(const LAS bf16x8*)(sp##X + o_bk); \
        const unsigned v16##X = *(const LAS unsigned short*)(sp##X + o_v);
#define SC_DOT(X, yv_)   \
        const f32x4 Da##X = __builtin_amdgcn_mfma_f32_16x16x32_bf16(a0##X, Tb0, z4, 0, 0, 0), Db##X = __builtin_amdgcn_mfma_f32_16x16x32_bf16(a1##X, Tb1, z4, 0, 0, 0); \
        const f32x2 D##X = {Da##X[0] + Db##X[0], Da##X[1] + Db##X[1]}; \
        yv_ = D##X[0];
#define SC_STEP(X, yv_) { SC_DOT(X, yv_) \
        const unsigned pk_ = cvt_pk_bf16(D##X[1], __uint_as_float(v16##X << 16)); \
        const unsigned pz_ = j == 0 ? pk_ : 0u; \
        T0 = __builtin_amdgcn_mfma_f32_16x16x32_bf16(bk##X, __builtin_bit_cast(bf16x8, (u32x4){pz_, 0u, 0u, 0u}), T0 * w0##X, 0, 0, 0); \
        T1 = __builtin_amdgcn_mfma_f32_16x16x32_bf16(bk##X, __builtin_bit_cast(bf16x8, (u32x4){0u, pz_, 0u, 0u}), T1 * w1##X, 0, 0, 0); \
        T2 = __builtin_amdgcn_mfma_f32_16x16x32_bf16(bk##X, __builtin_bit_cast(bf16x8, (u32x4){0u, 0u, pz_, 0u}), T2 * w2##X, 0, 0, 0); \
        T3 = __builtin_amdgcn_mfma_f32_16x16x32_bf16(bk##X, __builtin_bit_cast(bf16x8, (u32x4){0u, 0u, 0u, pz_}), T3 * w3##X, 0, 0, 0); \
        Tb0 = __builtin_bit_cast(bf16x8, (u32x4){cvt_pk_bf16(T0[0], T0[1]), cvt_pk_bf16(T0[2], T0[3]), cvt_pk_bf16(T1[0], T1[1]), cvt_pk_bf16(T1[2], T1[3])}); \
        Tb1 = __builtin_bit_cast(bf16x8, (u32x4){cvt_pk_bf16(T2[0], T2[1]), cvt_pk_bf16(T2[2], T2[3]), cvt_pk_bf16(T3[0], T3[1]), cvt_pk_bf16(T3[2], T3[3])}); }
#define CO_FLUSH(kk_, third_) do { if (tid < 64) { const int st_ = tid >> 3, cc_ = (tid & 7) * 8; const LAS float* ys_ = (const LAS float*)(lds + S_Y + (third_) * S_YB) + st_ * 64 + cc_; \
        const f32x4 y0_ = *(const LAS f32x4*)ys_, y1_ = *(const LAS f32x4*)(ys_ + 4); float f_[8] = {y0_[0], y0_[1], y0_[2], y0_[3], y1_[0], y1_[1], y1_[2], y1_[3]}; \
        if (!NOLD) *(bf16x8*)(Yo + (size_t)scan_row(b, (kk_) * TS + st_, dir) * 512 + h * 64 + cc_) = pack8(f_); else asm volatile("" :: "v"(f_[0])); } } while (0)
    int k3 = 0;
#pragma unroll 1
    for (int k = 0; k < T; ++k) {
        const int kp1 = k3 == 2 ? 0 : k3 + 1, km1 = k3 == 0 ? 2 : k3 - 1;
        if (k <= NTS) {
            if (ROLE != 1) {
                if (k + 1 <= NTS) { CO_WROP(ra, k + 1, sA, dstA, bkA); if (hasB) CO_WROP(rb, k + 1, sB, dstB, bkB); }
                if (ROLE == 0) { if (k + 2 <= NTS && !NOLD) { ra = CO_LDOP(k + 2, sA, srcA, shA); if (hasB) rb = CO_LDOP(k + 2, sB, srcB, shB); } }
                else { ra = rc; rb = rd; if (k + 3 <= NTS && !NOLD) { rc = CO_LDOP(k + 3, sA, srcA, shA); if (hasB) rd = CO_LDOP(k + 3, sB, srcB, shB); } }
                if (k >= 2) CO_FLUSH(k - 2, kp1);
            }
            const LAS char* buf = lds + S_SB + (k & 1) * S_SBB;
            if (ROLE == 2) {} else if (k < NTS) {
                float y0, y1, y2, y3, y4, y5, y6, y7;
                { SC_LD(A, 0) SC_LD(B, 1) SC_STEP(A, y0) SC_LD(C, 2) SC_STEP(B, y1) SC_LD(D, 3) SC_STEP(C, y2) SC_LD(E, 4) SC_STEP(D, y3)
                  SC_LD(F, 5) SC_STEP(E, y4) SC_LD(G, 6) SC_STEP(F, y5) SC_LD(H, 7) SC_STEP(G, y6) SC_STEP(H, y7) }
                if (j == 0) { yr[(km1 * 8 + 7) * 64] = y0; LAS float* y_ = yr + k3 * 512; y_[0] = y1; y_[64] = y2; y_[128] = y3; y_[192] = y4; y_[256] = y5; y_[320] = y6; y_[384] = y7; }
            } else { float y0; { SC_LD(A, 0) SC_DOT(A, y0) } if (j == 0) yr[(km1 * 8 + 7) * 64] = y0; }
        } else if (k == NTS + 1 && ROLE != 1) CO_FLUSH(NTS - 1, kp1);
        k3 = kp1;
        CO_BAR_S();
    }
    if (ROLE == 1) __builtin_amdgcn_s_setprio(0);
#undef CO_LDOP
#undef CO_WROP
#undef CO_SRC
#undef CO_DST
#undef CO_G
#undef CO_FLUSH
#undef SC_LD
#undef SC_DOT
#undef SC_STEP
}

struct AUnit { int b, h, qrow, rope, nk; };
__device__ __forceinline__ AUnit a_unit(int i, int bid) {
    AUnit u;
    if (i < 8) { const int x = bid & 7, jj = bid >> 3, pair = i * 16 + x * 2 + (jj >> 4), qh = jj & 15; u.b = pair >> 3; u.h = pair & 7; u.qrow = LC + qh * 128; u.rope = qh * 128; u.nk = LT; }
    else { const int pair = bid >> 1, half = bid & 1; u.b = pair >> 3; u.h = pair & 7; u.qrow = half * 128; u.rope = -1; u.nk = LC; }
    return u;
}
__device__ __forceinline__ void attn_role(const Params& p, LAS unsigned char* ldsb, int bid, int Tatt, int T) {
    using namespace att;
    LAS char* lds = (LAS char*)ldsb;
    const int tid = tid_() - 256, aw = __builtin_amdgcn_readfirstlane(tid >> 6), lane = tid & 63, r32 = lane & 31, hi = lane >> 5;
    const bf16_t* Q = (const bf16_t*)(p.ws + WS_Q); const bf16_t* KV = (const bf16_t*)(p.ws + WS_KV); const bf16_t* KRb = (const bf16_t*)(p.ws + WS_KR);
    bf16_t* MIX = (bf16_t*)(p.ws + WS_MIX);
    const float* COS = (const float*)(p.ws + WS_COS); const float* SIN = (const float*)(p.ws + WS_SIN);
    LAS float* ws = (LAS float*)(lds + A_WS) + aw * 64; LAS float* li_l = ws; LAS float* al_l = ws + 32;
    int offV[4], offK[4], offR[2];
#pragma unroll
    for (int n = 0; n < 4; ++n) { const int pp = (aw + 4 * n) * 1024 + lane * 16;
        { const int sub = pp >> 9, within = (pp & 511) >> 1, kk = (sub >> 2) * 8 + (within >> 5), c = (sub & 3) * 32 + (within & 31);
          const int k = (kk & ~0xC) | ((kk & 4) << 1) | ((kk & 8) >> 1); offV[n] = k * 2048 + c; }
        { const int rowk = pp >> 8, colB = (pp & 255) ^ ((rowk & 7) << 4); offK[n] = rowk * 2048 + (colB >> 1); } }
#pragma unroll
    for (int n = 0; n < 2; ++n) { const int pp = (aw + 4 * n) * 1024 + lane * 16; const int rowk = pp >> 7, chunk = ((pp & 127) >> 4) ^ ((rowk >> 1) & 7); offR[n] = rowk * 64 + chunk * 8; }
    const int krsw = ((r32 >> 1) & 7);
    const int vb0 = (int)(uintptr_t)(lds + A_V) + v_rd_base(lane);
#define CO_DMA(kk_) do { const int ui_ = (kk_) < 288 ? (kk_) / 36 : 8, j_ = (kk_) < 288 ? (kk_) % 36 : (kk_) - 288; const AUnit u_ = a_unit(ui_, bid); \
        const size_t kr0_ = (size_t)u_.b * LT + (size_t)j_ * 64; const bf16_t* kn_ = KV + kr0_ * 2048 + u_.h * 256; const bf16_t* kr_ = KRb + kr0_ * 64; const int bs_ = ((kk_) & 1); \
        _Pragma("unroll") for (int n = 0; n < 4; ++n) { \
            __builtin_amdgcn_global_load_lds((const unsigned*)(kn_ + 128 + offV[n]), (LAS unsigned*)(lds + A_V + bs_ * 16384 + (aw + 4 * n) * 1024), 16, 0, 0); \
            __builtin_amdgcn_global_load_lds((const unsigned*)(kn_ + offK[n]), (LAS unsigned*)(lds + A_KN + bs_ * 16384 + (aw + 4 * n) * 1024), 16, 0, 0); } \
        _Pragma("unroll") for (int n = 0; n < 2; ++n) \
            __builtin_amdgcn_global_load_lds((const unsigned*)(kr_ + offR[n]), (LAS unsigned*)(lds + A_KR + bs_ * 8192 + (aw + 4 * n) * 1024), 16, 0, 0); } while (0)
    float m_reg = -1e30f, l_reg = 0.f; f32x16 o[4]; bf16x8 qr[12];
#pragma unroll
    for (int d = 0; d < 4; ++d)
#pragma unroll
        for (int r = 0; r < 16; ++r) o[d][r] = 0.f;
#pragma unroll
    for (int d0 = 0; d0 < 12; ++d0)
#pragma unroll
        for (int i = 0; i < 8; ++i) qr[d0][i] = 0;
    if (Tatt > 0) CO_DMA(0);
    CO_BAR();
#pragma unroll 1
    for (int k = 0; k < T; ++k) {
        if (k < Tatt) {
            const int ui = k < 288 ? k / 36 : 8, j = k < 288 ? k % 36 : k - 288; const AUnit u = a_unit(ui, bid); const int ntu = u.nk / KVBLK;
            const size_t r0 = (size_t)u.b * LT + u.qrow + aw * QBLK;
            if (k + 1 < Tatt) CO_DMA(k + 1);
            if (j == 0) {
                const bf16_t* Qw = Q + (r0 + r32) * 1536 + u.h * 192 + hi * 8;
#pragma unroll
                for (int d0 = 0; d0 < 8; ++d0) qr[d0] = *(const bf16x8*)(Qw + d0 * 16);
#pragma unroll
                for (int d0 = 8; d0 < 12; ++d0) { bf16x8 x = *(const bf16x8*)(Qw + 128 + (d0 - 8) * 16);
                    if (u.rope >= 0) { const int pos = u.rope + aw * QBLK + r32, pi = (d0 - 8) * 8 + hi * 4;
                        const f32x4 c = *(const f32x4*)(COS + pos * 32 + pi), s = *(const f32x4*)(SIN + pos * 32 + pi);
                        float f[8]; unpack8(x, f); float g[8];
#pragma unroll
                        for (int i = 0; i < 4; ++i) { g[2 * i] = f[2 * i] * c[i] - f[2 * i + 1] * s[i]; g[2 * i + 1] = f[2 * i] * s[i] + f[2 * i + 1] * c[i]; }
                        x = pack8(g); }
                    qr[d0] = x; }
                m_reg = -1e30f; l_reg = 0.f;
#pragma unroll
                for (int d = 0; d < 4; ++d)
#pragma unroll
                    for (int r = 0; r < 16; ++r) o[d][r] = 0.f;
            }
            const int bsel = k & 1;
            f32x16 p0, p1;
#pragma unroll
            for (int r = 0; r < 16; ++r) { p0[r] = 0.f; p1[r] = 0.f; }
            { const LAS char* Kn_l = lds + A_KN + bsel * 16384; const LAS char* Kr_l = lds + A_KR + bsel * 8192;
#pragma unroll
              for (int d0 = 0; d0 < 8; ++d0) { const int cb = (d0 * 16 + hi * 8) * 2;
                const bf16x8 b0 = *(const LAS bf16x8*)(Kn_l + (r32 * 256 + (cb ^ ((r32 & 7) << 4)))), b1 = *(const LAS bf16x8*)(Kn_l + ((32 + r32) * 256 + (cb ^ ((r32 & 7) << 4))));
                p0 = __builtin_amdgcn_mfma_f32_32x32x16_bf16(b0, qr[d0], p0, 0, 0, 0); p1 = __builtin_amdgcn_mfma_f32_32x32x16_bf16(b1, qr[d0], p1, 0, 0, 0); }
#pragma unroll
              for (int d0 = 8; d0 < 12; ++d0) { const int ch = ((d0 - 8) * 2 + hi) ^ krsw;
                const bf16x8 b0 = *(const LAS bf16x8*)(Kr_l + r32 * 128 + ch * 16), b1 = *(const LAS bf16x8*)(Kr_l + (32 + r32) * 128 + ch * 16);
                p0 = __builtin_amdgcn_mfma_f32_32x32x16_bf16(b0, qr[d0], p0, 0, 0, 0); p1 = __builtin_amdgcn_mfma_f32_32x32x16_bf16(b1, qr[d0], p1, 0, 0, 0); } }
            float mn, alpha; partialSM(p0, p1, m_reg, mn, alpha);
            if (__any(alpha < 1.f)) { if (hi == 0) al_l[r32] = alpha; asm volatile("s_waitcnt lgkmcnt(0)" ::: "memory");
#pragma unroll
                for (int d = 0; d < 4; ++d)
#pragma unroll
                    for (int r = 0; r < 16; ++r) o[d][r] *= al_l[crow(r, hi)]; }
            bf16x8 pa0, pa1, pa2, pa3; finishSM(p0, p1, alpha, l_reg, pa0, pa1, pa2, pa3); __builtin_amdgcn_sched_barrier(0);
            { const int vb = vb0 + bsel * 16384;
              pv_one<0>(o[0], vb, pa0, pa1, pa2, pa3); pv_one<1>(o[1], vb, pa0, pa1, pa2, pa3); pv_one<2>(o[2], vb, pa0, pa1, pa2, pa3); pv_one<3>(o[3], vb, pa0, pa1, pa2, pa3); }
            if (j == ntu - 1) {
                if (hi == 0) li_l[r32] = l_reg; asm volatile("s_waitcnt lgkmcnt(0)" ::: "memory");
                bf16_t* Ow = MIX + r0 * 2048 + 512 + u.h * 128;
#pragma unroll
                for (int r = 0; r < 16; ++r) { const int orow = crow(r, hi); const float rl = __builtin_amdgcn_rcpf(li_l[orow]);
#pragma unroll
                    for (int d0 = 0; d0 < 4; ++d0) Ow[(size_t)orow * 2048 + d0 * 32 + r32] = f2bf(o[d0][r] * rl); }
            }
        }
        CO_BAR();
    }
#undef CO_DMA
}
#undef CO_BAR
#undef CO_BAR_S
}

template <int MODE>
__device__ __forceinline__ void corun_phase(const Params& p, LAS unsigned char* lds, int l, int bid) {
    const int Tatt = 288 + ((l < DEPTH - 1) ? 4 : 0), T = Tatt > co::NTS + 2 ? Tatt : co::NTS + 2;
    __syncthreads();
    if (__builtin_amdgcn_readfirstlane(tid_() >> 6) < 4) { if (MODE == 1 || MODE == 3) co::scan_role<(MODE == 3), 1>(p, lds, bid, T); else if (MODE != 2) co::scan_role<0, 0>(p, lds, bid, T); else { for (int k = 0; k <= T; ++k) __builtin_amdgcn_s_barrier(); } }
    else { if (MODE == 1 || MODE == 3) co::scan_role<(MODE == 3), 2>(p, lds, bid, T); else co::attn_role(p, lds, bid, Tatt, T); }
    __syncthreads();
}
struct DenseSched {
    const bf16_t* A; const bf16_t* Bt; int lda, K, nM, nN, G, c, skipctx;
    __device__ __forceinline__ bool next(int i, pg8::Unit& u) const {
        int pm, pn; if (!pg8::tile_order((long)i * G + c, nM, nN, pm, pn)) return false;
        if (skipctx) pm = (pm >> 3) * 9 + 1 + (pm & 7);
        u.a = (const char*)(A + (size_t)pm * 256 * lda); u.b = (const char*)(Bt + (size_t)pn * 256 * K); u.row0 = pm * 256; u.col0 = pn * 256; u.lst = nullptr; u.aux = 0; return true;
    }
};
struct MoeSched {
    const bf16_t* A; const bf16_t* Bt; size_t bstride; int lda, K, npn; const LAS int* toff; const int* list; int G, c, gather;
    __device__ __forceinline__ bool next(int i, pg8::Unit& u) const {
        const int cx = ((G & 7) == 0) ? (c & 7) * (G >> 3) + (c >> 3) : c;
        const int L = i * G + cx, T = toff[16]; if (L >= T * npn) return false;
        const int rt = L / npn, pn = L % npn; int e = 0;
#pragma unroll
        for (int j = 1; j < 16; ++j) e += (rt >= toff[j]) ? 1 : 0;
        const int mt = rt - toff[e];
        u.b = (const char*)(Bt + (size_t)e * bstride + (size_t)pn * 256 * K);
        if (gather) { u.a = (const char*)A; u.lst = list + (size_t)e * MT + mt * 256; } else { u.a = (const char*)(A + (size_t)rt * 256 * lda); u.lst = nullptr; }
        u.row0 = rt * 256; u.col0 = pn * 256; u.aux = e; return true;
    }
};

constexpr int NPH_LAYER = 10, NPH = 2 + DEPTH * NPH_LAYER;
#ifndef PH_MASK
#define PH_MASK 0xFFFFF
#endif
#define PH(k) ((PH_MASK >> (k)) & 1)
#ifndef REP_MASK
#define REP_MASK 0
#endif
#define REPS(k) (1 + ((REP_MASK >> (k)) & 1))
#ifndef CORUN_PROBE
#define CORUN_PROBE 0
#endif
#ifndef PREP_PROBE
#define PREP_PROBE 0
#endif
#ifndef SCAN_PROBE
#define SCAN_PROBE 0
#endif

#ifdef DET_CHECK
#ifndef DET_BITS
#define DET_BITS 3
#endif
__device__ __forceinline__ void det_hash(const Params& p, LAS unsigned char* lds, int l, int bid, unsigned& hy, unsigned& hm) {
    const int tid = tid_();
    LAS unsigned* acc = (LAS unsigned*)(lds + LDS_MISC + 8192);
    __builtin_amdgcn_fence(__ATOMIC_RELEASE, "agent"); __syncthreads(); __builtin_amdgcn_fence(__ATOMIC_ACQUIRE, "agent");
    if (tid < 2) acc[tid] = 0u;
    __syncthreads();
    unsigned a = 0, c = 0;
    { const int dir = bid & 1, h = (bid >> 1) & 7, b = bid >> 4; const bf16_t* Yo = (const bf16_t*)(p.ws + (dir ? WS_YB : WS_YF));
      for (int i = tid; i < LT * 8; i += NTHR) { const int t = i >> 3, cc = (i & 7) * 8; const u32x4 v = *(const u32x4*)(Yo + ((size_t)b * LT + t) * 512 + h * 64 + cc);
          a += (v[0] + 3u * v[1] + 5u * v[2] + 7u * v[3]) * (2u * (unsigned)i + 1u); } }
    { const bf16_t* MIX = (const bf16_t*)(p.ws + WS_MIX); const int nu = 8 + (l < DEPTH - 1 ? 1 : 0);
      for (int ui = 0; ui < nu; ++ui) { const co::AUnit u = co::a_unit(ui, bid);
          for (int i = tid; i < 128 * 16; i += NTHR) { const int r = i >> 4, cc = (i & 15) * 8; const u32x4 v = *(const u32x4*)(MIX + ((size_t)u.b * LT + u.qrow + r) * 2048 + 512 + u.h * 128 + cc);
              c += (v[0] + 3u * v[1] + 5u * v[2] + 7u * v[3]) * (2u * (unsigned)(ui * 2048 + i) + 1u); } } }
    __hip_atomic_fetch_add(acc, a, __ATOMIC_RELAXED, __HIP_MEMORY_SCOPE_WORKGROUP); __hip_atomic_fetch_add(acc + 1, c, __ATOMIC_RELAXED, __HIP_MEMORY_SCOPE_WORKGROUP);
    __syncthreads();
    hy = acc[0]; hm = acc[1];
    __syncthreads();
}
#endif
__global__ void __launch_bounds__(NTHR, 2) mega_fwd(Params p) {
    extern __shared__ __attribute__((aligned(16))) unsigned char shm[];
    LAS unsigned char* lds = (LAS unsigned char*)shm;
    const int tid = threadIdx.x, bid = blockIdx.x, G = gridDim.x;
    if (tid < 64) ((LAS unsigned*)(lds + LDS_MISC))[tid] = 0u;
    __syncthreads();
    XcdBarrier bar = xcd_barrier_post((unsigned*)(p.ws + WS_CTL) + CW_BAR, (volatile LAS unsigned*)(lds + LDS_MISC));
    const int lo = p.ph_lo, hi = p.ph_hi;
#define IN(k) (lo <= (k) && (k) < hi)
#ifndef DBL_BAR
#define DBL_BAR 0
#endif
#define YOUNG_ON() do { if (__builtin_amdgcn_readfirstlane((int)threadIdx.x) >= 256) __builtin_amdgcn_s_setprio(1); } while (0)
#define YOUNG_OFF() __builtin_amdgcn_s_setprio(0)
#define SEAM(k) do { if (IN(k) && IN((k) + 1)) { xcd_barrier(bar); if (DBL_BAR) xcd_barrier(bar); } } while (0)
    if (IN(0)) { YOUNG_ON(); if (PH(0)) { mod_phase(p, lds, bid, G); rope_tables(p, bid, G); } if (PH(15)) { _Pragma("unroll") for (int rp = 0; rp < REPS(15); ++rp) convert_weights(p, lds, 0, bid, G); } YOUNG_OFF(); }
    SEAM(0);
    if (IN(1)) { YOUNG_ON(); if (PH(1)) modulate_phase(p, 0, bid, G); YOUNG_OFF(); }
    SEAM(1);
    const Params& p0 = p; const int bid0 = bid, G0 = G;
    for (int l = 0; l < DEPTH; ++l) {
        const int pb = 2 + l * NPH_LAYER;
        Params p = p0; int bid = bid0, G = G0;
        { unsigned char* w_ = p.ws; float* o_ = p.out; asm volatile("" : "+s"(w_), "+s"(o_), "+s"(bid), "+s"(G)); p.ws = w_; p.out = o_; }
        if (IN(pb + 0) && PH(2)) {
            DenseSched S{(const bf16_t*)(p.ws + WS_ACT), (const bf16_t*)(p.ws + WS_WIN), DM, DM, MT / 256, NPC / 256, G, bid, 0};
            pg8::EpiBf16<0> E{(bf16_t*)(p.ws + WS_P), NPC, nullptr};
            _Pragma("unroll") for (int rp = 0; rp < REPS(2); ++rp) pg8::gemm_phase<pg8::EpiBf16<0>, DenseSched, false>(lds, DM, DM, S, E, 0);
        }
        SEAM(pb + 0);
        if (IN(pb + 1)) { if (PH(3)) { YOUNG_ON(); prep_phase<0>(p, lds, l, bid, G); YOUNG_OFF(); if (REPS(3) > 1) prep_phase<PREP_PROBE>(p, lds, l, bid, G); } }
        SEAM(pb + 1);
#ifndef USE_CORUN
#define USE_CORUN 1
#endif
        const bool corun = USE_CORUN && (G == 256);
        if (IN(pb + 2)) {
            if (PH(5)) { YOUNG_ON(); _Pragma("unroll") for (int rp = 0; rp < REPS(5); ++rp) ret_phase(p, lds, bid, G); YOUNG_OFF(); }
            if (PH(6)) {
                DenseSched S{(const bf16_t*)(p.ws + WS_P) + PC_CQ, (const bf16_t*)(p.ws + WS_WUQ), NPC, 512, MT / 256, 1536 / 256, G, bid, 0};
                pg8::EpiBf16<0> E{(bf16_t*)(p.ws + WS_Q), 1536, (const float*)(p.ws + WS_RSQ)};
                _Pragma("unroll") for (int rp = 0; rp < REPS(6); ++rp) pg8::gemm_phase<pg8::EpiBf16<0>, DenseSched, false>(lds, 512, NPC, S, E, 0);
            }
            if (PH(7)) {
                DenseSched S{(const bf16_t*)(p.ws + WS_P) + PC_CKV, (const bf16_t*)(p.ws + WS_WUKV), NPC, 256, MT / 256, 2048 / 256, G, bid, 0};
                pg8::EpiBf16<0> E{(bf16_t*)(p.ws + WS_KV), 2048, (const float*)(p.ws + WS_RSKV)};
                _Pragma("unroll") for (int rp = 0; rp < REPS(7); ++rp) pg8::gemm_phase<pg8::EpiBf16<0>, DenseSched, false>(lds, 256, NPC, S, E, 0);
            }
        }
        SEAM(pb + 2);
#ifndef SEQ_SCAN
#define SEQ_SCAN 1
#endif
#ifdef DET_CHECK
        if (IN(pb + 3)) { unsigned hy0 = 0, hm0 = 0;
            for (int rp = 0; rp < DET_CHECK; ++rp) { corun_phase<0>(p, lds, l, bid); unsigned hy, hm; det_hash(p, lds, l, bid, hy, hm);
                if (rp == 0) { hy0 = hy; hm0 = hm; } else if (threadIdx.x == 0) { const unsigned bad = ((hy != hy0 ? 1u : 0u) | (hm != hm0 ? 2u : 0u)) & DET_BITS; if (bad) atomicOr((unsigned*)(p.ws + WS_CTL) + CW_DET, bad); } } }
#else
        if (IN(pb + 3)) { if (corun) { if (PH(8)) { if (SEQ_SCAN) { corun_phase<1>(p, lds, l, bid); attn_phase(p, lds, l, bid, G); } else corun_phase<0>(p, lds, l, bid); if (REPS(8) > 1) corun_phase<CORUN_PROBE>(p, lds, l, bid); } } else if (PH(8)) attn_phase(p, lds, l, bid, G); }
#endif
        SEAM(pb + 3);
        if (IN(pb + 4)) { YOUNG_ON(); if (PH(9)) finish_phase(p, l, bid, G); YOUNG_OFF(); }
        SEAM(pb + 4);
        if (IN(pb + 5) && PH(10)) {
            const int last = (l == DEPTH - 1);
            DenseSched S{(const bf16_t*)(p.ws + WS_MIX), (const bf16_t*)(p.ws + WS_WOUT), DM, DM, last ? NB * 8 : MT / 256, DM / 256, G, bid, last};
            pg8::EpiBf16<0> E{(bf16_t*)(p.ws + WS_MO), DM, nullptr};
            _Pragma("unroll") for (int rp = 0; rp < REPS(10); ++rp) pg8::gemm_phase<pg8::EpiBf16<0>, DenseSched, false>(lds, DM, DM, S, E, 0);
        }
        SEAM(pb + 5);
        if (IN(pb + 6)) { if (PH(11)) { YOUNG_ON(); ln1_phase<0>(p, lds, l, bid, G); YOUNG_OFF(); if (REPS(11) > 1) ln1_phase<1>(p, lds, l, bid, G); } }
        SEAM(pb + 6);
        if (IN(pb + 7) && PH(12)) {
            moe_prefix(p, lds, l);
            MoeSched S{(const bf16_t*)(p.ws + WS_ACT), (const bf16_t*)(p.ws + WS_W13), (size_t)1024 * DM, DM, DM, 4, (const LAS int*)(lds + LDS_MISC + 64), (const int*)(p.ws + WS_LIST), G, bid, 1};
            pg8::EpiBf16<1> E{(bf16_t*)(p.ws + WS_H), DEXP, nullptr};
            _Pragma("unroll") for (int rp = 0; rp < REPS(12); ++rp) pg8::gemm_phase<pg8::EpiBf16<1>, MoeSched, true>(lds, DM, DM, S, E, MT - 1);
        }
        SEAM(pb + 7);
        if (IN(pb + 8) && PH(13)) {
            moe_prefix(p, lds, l);
            MoeSched S{(const bf16_t*)(p.ws + WS_H), (const bf16_t*)(p.ws + WS_W2), (size_t)DM * DEXP, DEXP, DEXP, 8, (const LAS int*)(lds + LDS_MISC + 64), nullptr, G, bid, 0};
            pg8::EpiBf16<0> E{(bf16_t*)(p.ws + WS_Y), DM, nullptr};
            _Pragma("unroll") for (int rp = 0; rp < REPS(13); ++rp) pg8::gemm_phase<pg8::EpiBf16<0>, MoeSched, false>(lds, DEXP, DEXP, S, E, 0);
        }
        SEAM(pb + 8);
        if (IN(pb + 9)) { if (PH(14)) { YOUNG_ON(); ln2_phase<0>(p, lds, l, bid, G); YOUNG_OFF(); if (REPS(14) > 1) ln2_phase<1>(p, lds, l, bid, G); } if (PH(15) && l + 1 < DEPTH) { YOUNG_ON(); _Pragma("unroll") for (int rp = 0; rp < REPS(15); ++rp) convert_weights(p, lds, l + 1, bid, G); YOUNG_OFF(); } }
        SEAM(pb + 9);
    }
#ifdef DET_CHECK
    { const unsigned f = __hip_atomic_load((unsigned*)(p.ws + WS_CTL) + CW_DET, __ATOMIC_RELAXED, __HIP_MEMORY_SCOPE_AGENT);
      if (f && threadIdx.x == 0) p.out[(size_t)bid * 4096 + (f & 3)] = __builtin_nanf(""); }
#endif
#undef IN
#undef SEAM
}

extern "C" void kernel_launch(void* const* d_in, const int* in_sizes, int n_in, void* d_out, int out_size, void* d_ws, size_t ws_size, hipStream_t stream) {
    static int grid = 0;
    if (grid == 0) {
        if (n_in != 34 || ws_size < WS_END) { fprintf(stderr, "kernel_launch: need 34 inputs and >= %zu bytes of workspace; got n_in %d, ws %zu; nothing launched\n", (size_t)WS_END, n_in, ws_size); grid = -1; return; }
        int dev = 0, cus = 0, per_cu = 0;
        if (hipGetDevice(&dev) != hipSuccess || hipDeviceGetAttribute(&cus, hipDeviceAttributeMultiprocessorCount, dev) != hipSuccess) { fprintf(stderr, "kernel_launch: device query failed\n"); grid = -1; return; }
        if (hipFuncSetAttribute((const void*)mega_fwd, hipFuncAttributeMaxDynamicSharedMemorySize, LDS_BYTES) != hipSuccess) { fprintf(stderr, "kernel_launch: hipFuncSetAttribute failed\n"); grid = -1; return; }
        if (hipOccupancyMaxActiveBlocksPerMultiprocessor(&per_cu, (const void*)mega_fwd, NTHR, LDS_BYTES) != hipSuccess || per_cu < 1)
            fprintf(stderr, "kernel_launch: note: occupancy query reports %d workgroups per CU\n", per_cu);
        (void)hipGetLastError();
        grid = cus;
        if (grid != 256) fprintf(stderr, "kernel_launch: this kernel is built for 256 CUs (one RWKV scan per workgroup); found %d\n", cus);
    }
    if (grid < 0) return;
    if (hipMemsetAsync((char*)d_ws + WS_CTL, 0, CTL_BYTES, stream) != hipSuccess) { fprintf(stderr, "kernel_launch: memset failed\n"); return; }
    Params p;
    memset(&p, 0, sizeof(p));
    for (int i = 0; i < 34; ++i) p.in[i] = (const float*)d_in[i];
    p.out = (float*)d_out; p.ws = (unsigned char*)d_ws;
#ifndef MK_PER_PHASE
    p.ph_lo = 0; p.ph_hi = NPH;
#ifdef DBG_PHI
    p.ph_hi = DBG_PHI;
#endif
    hipLaunchKernelGGL(mega_fwd, dim3(grid), dim3(NTHR), LDS_BYTES, stream, p);
#else
    for (int k = 0; k < NPH; ++k) { p.ph_lo = k; p.ph_hi = k + 1; hipLaunchKernelGGL(mega_fwd, dim3(grid), dim3(NTHR), LDS_BYTES, stream, p); }
#endif
    const hipError_t le = hipPeekAtLastError();
    if (le != hipSuccess) fprintf(stderr, "kernel_launch: launch failed: %s\n", hipGetErrorName(le));
}
```

```cpp
#include <hip/hip_runtime.h>
#include <cstdio>
#include <cstdint>
#include <cstring>

#define LAS __attribute__((address_space(3)))
#ifndef DBG_MASK
#define DBG_MASK 0
#endif
typedef unsigned short bf16_t;
typedef short bf16x8 __attribute__((ext_vector_type(8)));
typedef short s16x4 __attribute__((ext_vector_type(4)));
typedef float f32x2 __attribute__((ext_vector_type(2)));
typedef float f32x4 __attribute__((ext_vector_type(4)));
typedef float f32x8 __attribute__((ext_vector_type(8)));
typedef float f32x16 __attribute__((ext_vector_type(16)));
typedef unsigned u32x2 __attribute__((ext_vector_type(2)));
typedef unsigned u32x4 __attribute__((ext_vector_type(4)));

constexpr int NB = 16, LC = 256, LL = 2048, LT = LC + LL, MT = NB * LT;
constexpr int DM = 2048, DEPTH = 4;
constexpr int NPC = 4352;
constexpr int IN_COLS = 4128;
constexpr int NEXP = 16, DEXP = 512;
constexpr float ALPHA_F = 1.681792830507429f;
constexpr float LN_EPS_F = 1e-5f;
constexpr int PC_R = 0, PC_K = 512, PC_V = 1024, PC_CQ = 1536, PC_CKV = 2048, PC_RQ = 2304, PC_RK = 2560, PC_RV = 2816, PC_RG = 3328,
              PC_WD = 3840, PC_AD = 3904, PC_GD = 3968, PC_KR = 4064;
constexpr int OPS_HW = 704, OPS_W = 8 * OPS_HW;
constexpr int MAXTILES = 304;

constexpr size_t al256(size_t x) { return (x + 255) / 256 * 256; }
constexpr size_t WS_CTL = 0, CTL_BYTES = 65536;
constexpr size_t WS_MOD = WS_CTL + CTL_BYTES;
constexpr size_t WS_COS = WS_MOD + al256((size_t)DEPTH * 17 * 12288 * 4);
constexpr size_t WS_SIN = WS_COS + (size_t)2048 * 32 * 4;
constexpr size_t WS_WIN = WS_SIN + (size_t)2048 * 32 * 4;
constexpr size_t WS_WOUT = WS_WIN + (size_t)NPC * DM * 2;
constexpr size_t WS_WUQ = WS_WOUT + (size_t)DM * DM * 2;
constexpr size_t WS_WUKV = WS_WUQ + (size_t)1536 * 512 * 2;
constexpr size_t WS_W13 = WS_WUKV + (size_t)2048 * 256 * 2;
constexpr size_t WS_W2 = WS_W13 + (size_t)NEXP * 1024 * DM * 2;
constexpr size_t WS_WUP = WS_W2 + (size_t)NEXP * DM * DEXP * 2;
constexpr size_t WS_AUP = WS_WUP + (size_t)2 * 512 * 32 * 2;
constexpr size_t WS_GUP = WS_AUP + (size_t)2 * 512 * 32 * 2;
constexpr size_t WS_XC = al256(WS_GUP + (size_t)512 * 96 * 2);
constexpr size_t WS_ACT = WS_XC;
constexpr size_t WS_P = WS_ACT + (size_t)MT * DM * 2;
constexpr size_t WS_OPS = WS_P + (size_t)MT * NPC * 2;
constexpr size_t WS_Q = WS_OPS + (size_t)MT * OPS_W * 2;
constexpr size_t WS_KV = WS_Q + (size_t)MT * 1536 * 2;
constexpr size_t WS_KR = WS_KV + (size_t)MT * 2048 * 2;
constexpr size_t WS_RQ = WS_KR + (size_t)MT * 64 * 2;
constexpr size_t WS_RK = WS_RQ + (size_t)MT * 256 * 2;
constexpr size_t WS_YF = WS_RK + (size_t)MT * 256 * 2;
constexpr size_t WS_YB = WS_YF + (size_t)MT * 512 * 2;
constexpr size_t WS_OF = WS_YB + (size_t)MT * 512 * 2;
constexpr size_t WS_OB = WS_OF + (size_t)MT * 512 * 2;
constexpr size_t WS_XB = WS_OB + (size_t)MT * 512 * 2;
constexpr size_t WS_G = WS_XB + (size_t)MT * DM * 2;
constexpr size_t WS_BON = WS_G + (size_t)MT * 512 * 2;
constexpr size_t WS_RSQ = WS_BON + (size_t)MT * 8 * 4;
constexpr size_t WS_RSKV = WS_RSQ + (size_t)MT * 4;
constexpr size_t WS_VSH = al256(WS_RSKV + (size_t)MT * 4);
constexpr size_t WS_END = al256(WS_VSH + (size_t)MT * 512 * 2);
constexpr size_t WS_MIX = WS_ACT;
constexpr size_t WS_H = WS_OPS + (size_t)160 * 1024 * 1024;
constexpr size_t WS_MO = WS_P;
constexpr size_t WS_Y = WS_P;
constexpr size_t WS_LIST = WS_KV;
constexpr size_t WS_TINF = WS_KV + (size_t)NEXP * MT * 4;
static_assert((size_t)MT * DM * 2 <= (size_t)160 * 1024 * 1024 && WS_H + (size_t)MAXTILES * 256 * 512 * 2 <= WS_Q, "overlay H");
static_assert((size_t)MAXTILES * 256 * 2048 * 2 <= (size_t)MT * NPC * 2, "overlay Y");
static_assert(WS_TINF + (size_t)MT * 32 <= WS_KR, "overlay LIST/TINF");

constexpr int CW_BAR = 0;
constexpr int CW_DET = 3968;
constexpr int CW_CNT = 4096;

struct Params {
    const float* in[34];
    float* out;
    unsigned char* ws;
    int ph_lo, ph_hi;
};

__device__ __forceinline__ float bf2f(bf16_t b) { return __uint_as_float(((unsigned)b) << 16); }
typedef __bf16 bf16x2_t __attribute__((ext_vector_type(2)));
__device__ __forceinline__ unsigned cvt_pk_bf16(float lo, float hi) { const f32x2 v = {lo, hi}; return __builtin_bit_cast(unsigned, __builtin_convertvector(v, bf16x2_t)); }
__device__ __forceinline__ bf16_t f2bf(float f) { return __builtin_bit_cast(bf16_t, (__bf16)f); }
__device__ __forceinline__ float sigmoidf_(float x) { return __builtin_amdgcn_rcpf(1.0f + __expf(-x)); }
__device__ __forceinline__ float siluf_(float x) { return x * __builtin_amdgcn_rcpf(1.0f + __expf(-x)); }
__device__ __forceinline__ void unpack8(const bf16x8 v, float (&f)[8]) {
#pragma unroll
    for (int i = 0; i < 8; ++i) f[i] = bf2f((bf16_t)v[i]);
}
__device__ __forceinline__ bf16x8 pack8(const float (&f)[8]) {
    u32x4 w; w.x = cvt_pk_bf16(f[0], f[1]); w.y = cvt_pk_bf16(f[2], f[3]); w.z = cvt_pk_bf16(f[4], f[5]); w.w = cvt_pk_bf16(f[6], f[7]);
    return *reinterpret_cast<bf16x8*>(&w);
}
__device__ __forceinline__ int tid_() { int t = threadIdx.x; asm volatile("" : "+v"(t)); return t; }
#define XB_TMO      128
#define XB_XCNT(j)  (256  + 64 * (j))
#define XB_XSUB(j)  (1280 + 64 * (j))
#define XB_XGEN(j)  (2304 + 64 * (j))
#define XB_TOP      3328
#define XB_TOPGEN   3392
#define XCD_BAR_WORDS 3456
#define XB_SPIN_CAP (1u << 18)

__device__ __forceinline__ unsigned xb_ld(unsigned* p)              { return __hip_atomic_load(p, __ATOMIC_RELAXED, __HIP_MEMORY_SCOPE_AGENT); }
__device__ __forceinline__ unsigned xb_add(unsigned* p, unsigned v) { return __hip_atomic_fetch_add(p, v, __ATOMIC_RELAXED, __HIP_MEMORY_SCOPE_AGENT); }
__device__ __forceinline__ unsigned xb_xcc_id() { return (unsigned)__builtin_amdgcn_s_getreg((3 << 11) | 20) & 0xFu; }
#define XB_SPIN(cond, bar) do { unsigned _sp = 0; while (cond) { __builtin_amdgcn_s_sleep(1); \
    if ((++_sp & 255u) == 0u) { if (xb_ld(&(bar)[XB_TMO])) break; if (_sp > XB_SPIN_CAP) { atomicAdd(&(bar)[XB_TMO], 1u); break; } } } } while (0)

struct XcdBarrier {
    unsigned* bar; unsigned x;
    volatile LAS unsigned* st;
};

__device__ __forceinline__ XcdBarrier xcd_barrier_post(unsigned* bar, volatile LAS unsigned* st) {
    XcdBarrier b; b.bar = bar; b.x = xb_xcc_id(); b.st = st;
    if (threadIdx.x == 0) (void)xb_add(&bar[XB_XCNT(b.x)], 1u);
    return b;
}
__device__ __forceinline__ void xcd_barrier_complete(unsigned* bar, unsigned x, unsigned& nloc, unsigned& nx) {
    const unsigned G = gridDim.x * gridDim.y * gridDim.z;
    unsigned sum, cnt, mine, sp = 0u;
    for (;;) {
        sum = 0u; cnt = 0u; mine = 0u;
#pragma unroll
        for (unsigned j = 0; j < 16; ++j) { const unsigned c = xb_ld(&bar[XB_XCNT(j)]); sum += c; cnt += (c > 0u) ? 1u : 0u; mine = (j == x) ? c : mine; }
        if (sum == G) break;
        __builtin_amdgcn_s_sleep(1);
        if ((++sp & 255u) == 0u) { if (xb_ld(&bar[XB_TMO])) break; if (sp > XB_SPIN_CAP) { atomicAdd(&bar[XB_TMO], 1u); break; } }
    }
    nloc = mine > 0u ? mine : 1u; nx = cnt > 0u ? cnt : 1u;
}

__device__ __forceinline__ void xcd_barrier(const XcdBarrier& b) {
    asm volatile("s_waitcnt vmcnt(0)" ::: "memory");
    __syncthreads();
    if (threadIdx.x == 0) {
        unsigned* bar = b.bar;
        __builtin_amdgcn_s_waitcnt(0);
        unsigned nloc = b.st[0], nx = b.st[1];
        if (nloc == 0u) { xcd_barrier_complete(bar, b.x, nloc, nx); b.st[0] = nloc; b.st[1] = nx; }
        const unsigned old = xb_add(&bar[XB_XSUB(b.x)], 1u);
        const unsigned gen = old / nloc;
        if (old + 1u == (gen + 1u) * nloc) {
            __builtin_amdgcn_fence(__ATOMIC_RELEASE, "agent");
            asm volatile("s_waitcnt vmcnt(0)" ::: "memory");
            const unsigned og = xb_add(&bar[XB_TOP], 1u);
            const unsigned tg = og / nx;
            if (og + 1u == (tg + 1u) * nx) xb_add(&bar[XB_TOPGEN], 1u);
            else XB_SPIN(xb_ld(&bar[XB_TOPGEN]) == tg, bar);
            __builtin_amdgcn_fence(__ATOMIC_ACQUIRE, "agent");
            xb_add(&bar[XB_XGEN(b.x)], 1u);
            asm volatile("s_waitcnt vmcnt(0)" ::: "memory");
        } else {
            XB_SPIN(xb_ld(&bar[XB_XGEN(b.x)]) == gen, bar);
            __builtin_amdgcn_fence(__ATOMIC_ACQUIRE, "agent");
            asm volatile("s_waitcnt vmcnt(0)" ::: "memory");
        }
    }
    __syncthreads();
}
namespace pg8 {
constexpr int BM = 256, BK = 64, HALF = 128, HTB = HALF * BK * 2  , STAGE_BYTES = 8 * HTB, NXCD = 8, WGM = 8;
__host__ __device__ __forceinline__ int lds_byte(int r, int c) { const int st = (r >> 4) * 2 + (c >> 5), rr = r & 15, cc = c & 31, ob = rr * 64 + cc * 2; return st * 1024 + (ob ^ (((ob >> 9) & 1) << 5)); }
__host__ __device__ __forceinline__ void stage_rc(int b, int& R, int& C) { const int st = b / 1024, sb = b % 1024, swz = sb ^ (((sb >> 9) & 1) << 5); R = (st >> 1) * 16 + swz / 64; C = (st & 1) * 32 + (swz % 64) / 2; }
__host__ __device__ __forceinline__ int perm32(int rho) { const int n = rho >> 4, i = rho & 15; return 8 * (i >> 2) + 4 * n + (i & 3); }

struct Unit { const char* a; const char* b; int row0, col0; const int* lst; int aux; };

__device__ __forceinline__ bool tile_order(long L, int nM, int nN, int& pm, int& pn) {
    const int nwg = nM * nN; if (L >= nwg) return false;
    int wgid = (int)L; { const int q = nwg / NXCD, r = nwg % NXCD, xcd = wgid % NXCD, off = wgid / NXCD; wgid = (xcd < r ? xcd * (q + 1) : r * (q + 1) + (xcd - r) * q) + off; }
    const int nig = WGM * nN, gid = wgid / nig, fm = gid * WGM, gsz = (nM - fm) < WGM ? (nM - fm) : WGM;
    pm = fm + ((wgid % nig) % gsz); pn = (wgid % nig) / gsz; return true;
}

template <int MODE> struct EpiBf16 {
    bf16_t* O; int ldc; const float* rs;
    __device__ __forceinline__ void operator()(const f32x4 (&acc)[2][2][4][2], const Unit& u, int wr, int wc, int fr, int fq) const {
        const int row0 = u.row0 + wr * 64 + fr;
#pragma unroll
        for (int ai = 0; ai < 2; ++ai)
#pragma unroll
            for (int m = 0; m < 4; ++m) {
                const int r = row0 + ai * HALF + m * 16;
                if (MODE == 0) {
                    const float sc = rs ? rs[r] : 1.0f;
                    bf16_t* rowp = O + (size_t)r * ldc + u.col0 + wc * 32 + 8 * fq;
#pragma unroll
                    for (int bj = 0; bj < 2; ++bj) { const f32x4 v0 = acc[ai][bj][m][0] * sc, v1 = acc[ai][bj][m][1] * sc;
                        u32x4 w; w.x = cvt_pk_bf16(v0[0], v0[1]); w.y = cvt_pk_bf16(v0[2], v0[3]); w.z = cvt_pk_bf16(v1[0], v1[1]); w.w = cvt_pk_bf16(v1[2], v1[3]);
                        *(u32x4*)(rowp + bj * HALF) = w; }
                } else {
                    bf16_t* rowp = O + (size_t)r * ldc + (u.col0 >> 1) + wc * 16 + 4 * fq;
#pragma unroll
                    for (int bj = 0; bj < 2; ++bj) { const f32x4 a = acc[ai][bj][m][0], b = acc[ai][bj][m][1];
                        u32x2 w; w.x = cvt_pk_bf16(siluf_(a[0]) * b[0], siluf_(a[1]) * b[1]); w.y = cvt_pk_bf16(siluf_(a[2]) * b[2], siluf_(a[3]) * b[3]);
                        *(u32x2*)(rowp + bj * 64) = w; }
                }
            }
    }
};

template <class Epi, class Sched, bool GATHER>
__device__ __forceinline__ void gemm_phase(LAS unsigned char* lds, const int Kin, const int lda, const Sched& S, const Epi& E, const int gclamp) {
    int K = Kin; asm volatile("" : "+s"(K));
    const int tid = tid_(), wid = __builtin_amdgcn_readfirstlane(tid >> 6), lane = tid & 63, wr = wid >> 2, wc = wid & 3, fr = lane & 15, fq = lane >> 4;
    const int nt = K / BK;
    int Rr[2], Cc[2]; unsigned voffB[2];
#pragma unroll
    for (int i = 0; i < 2; ++i) { int R, C; stage_rc(tid * 16 + i * 8192, R, C); const int Rb = (R & ~31) + perm32(R & 31); Rr[i] = R; Cc[i] = C; voffB[i] = (unsigned)(Rb * K + C) * 2u; }
    const size_t kstep = (size_t)(BK * 2);
    const size_t hstepB = (size_t)HALF * K * 2;
    const unsigned ldsw = (unsigned)wid * 1024u;
    const int aoff = lds_byte(wr * 64 + fr, fq * 8), boff = lds_byte(wc * 32 + fr, fq * 8);
#define PG8_SA(b, h) (((b) * 2 + (h)) * HTB)
#define PG8_SB(b, h) ((4 + (b) * 2 + (h)) * HTB)
#define PG8_STAGE(bufoff, gbase, voff) do { _Pragma("unroll") for (int _i = 0; _i < 2; ++_i) \
        __builtin_amdgcn_global_load_lds((const unsigned*)((const char*)(gbase) + (voff)[_i]), (LAS unsigned*)(lds + (bufoff) + ldsw + _i * 8192), 16, 0, 0); } while (0)
#define PG8_LDA(dst, b, h) do { _Pragma("unroll") for (int m = 0; m < 4; ++m) _Pragma("unroll") for (int k = 0; k < 2; ++k) dst[m][k] = *(const LAS bf16x8*)(lds + PG8_SA(b, h) + aoff + m * 2048 + k * 1024); } while (0)
#define PG8_LDB(dst, b, h) do { _Pragma("unroll") for (int n = 0; n < 2; ++n) _Pragma("unroll") for (int k = 0; k < 2; ++k) dst[n][k] = *(const LAS bf16x8*)(lds + PG8_SB(b, h) + boff + n * 2048 + k * 1024); } while (0)
#define PG8_MMA(ai, bj, At, Bt) do { __builtin_amdgcn_s_setprio(1); _Pragma("unroll") for (int m = 0; m < 4; ++m) _Pragma("unroll") for (int n = 0; n < 2; ++n) _Pragma("unroll") for (int k = 0; k < 2; ++k) \
        acc[ai][bj][m][n] = __builtin_amdgcn_mfma_f32_16x16x32_bf16(Bt[n][k], At[m][k], acc[ai][bj][m][n], 0, 0, 0); __builtin_amdgcn_s_setprio(0); } while (0)
#define PG8_WAIT_V(n) asm volatile("s_waitcnt vmcnt(" #n ")" ::: "memory")
#define PG8_WAIT_L(n) asm volatile("s_waitcnt lgkmcnt(" #n ")" ::: "memory")
#define PG8_BAR __builtin_amdgcn_s_barrier()
#define PG8_SCHED __builtin_amdgcn_sched_barrier(0)
#define PG8_AOFF(dst, u) do { _Pragma("unroll") for (int _h = 0; _h < 2; ++_h) _Pragma("unroll") for (int _i = 0; _i < 2; ++_i) { \
        int _r = Rr[_i] + _h * HALF; if (GATHER) { unsigned _t = (unsigned)(u).lst[_r]; _r = (int)(_t < (unsigned)gclamp ? _t : (unsigned)gclamp); } \
        dst[_h][_i] = ((unsigned)_r * (unsigned)lda + (unsigned)Cc[_i]) * 2u; } } while (0)
    Unit cur, nxt; int ui = 0;
    if (!S.next(0, cur)) return;
    unsigned vA[2][2], vN[2][2];
    PG8_AOFF(vA, cur);
    bool has_next = S.next(1, nxt);
    if (GATHER) {
        if (has_next) { PG8_AOFF(vN, nxt); } else {
#pragma unroll
            for (int h = 0; h < 2; ++h) { vN[h][0] = vA[h][0]; vN[h][1] = vA[h][1]; } }
    }
    f32x4 acc[2][2][4][2];
#pragma unroll
    for (int a = 0; a < 2; ++a)
#pragma unroll
        for (int b = 0; b < 2; ++b)
#pragma unroll
            for (int m = 0; m < 4; ++m)
#pragma unroll
                for (int n = 0; n < 2; ++n) acc[a][b][m][n] = (f32x4){0.f, 0.f, 0.f, 0.f};
    bf16x8 At[4][2], B0[2][2], B1[2][2];
    const char* cA = cur.a; const char* cB = cur.b;
    PG8_STAGE(PG8_SB(0, 0), cB, voffB); PG8_STAGE(PG8_SA(0, 0), cA, vA[0]); PG8_STAGE(PG8_SB(0, 1), cB + hstepB, voffB); PG8_STAGE(PG8_SA(0, 1), cA, vA[1]);
    if (wr == 1) PG8_BAR;
    PG8_WAIT_V(4); PG8_BAR;
    PG8_STAGE(PG8_SB(1, 0), cB + kstep, voffB); PG8_STAGE(PG8_SA(1, 0), cA + kstep, vA[0]); PG8_STAGE(PG8_SB(1, 1), cB + hstepB + kstep, voffB);
    PG8_WAIT_V(6); PG8_BAR;
    for (;;) {
        const char* nA = has_next ? nxt.a : cA; const char* nB = has_next ? nxt.b : cB;
        for (int t = 0; t < nt; t += 2) {
            const bool last = (t == nt - 2);
            const char* a1 = cA + (size_t)(t + 1) * kstep;
            const char* a2 = last ? nA : cA + (size_t)(t + 2) * kstep; const char* b2 = last ? nB : cB + (size_t)(t + 2) * kstep;
            const char* a3 = a2 + kstep; const char* b3 = b2 + kstep;
            unsigned v2[2][2];
#pragma unroll
            for (int h = 0; h < 2; ++h) { v2[h][0] = (GATHER && last) ? vN[h][0] : vA[h][0]; v2[h][1] = (GATHER && last) ? vN[h][1] : vA[h][1]; }
            PG8_LDB(B0, 0, 0); PG8_SCHED; PG8_LDA(At, 0, 0); PG8_STAGE(PG8_SA(1, 1), a1, vA[1]);
            PG8_WAIT_L(8); PG8_BAR; PG8_WAIT_L(0); PG8_MMA(0, 0, At, B0); PG8_BAR; PG8_SCHED;
            PG8_LDB(B1, 0, 1); PG8_STAGE(PG8_SB(0, 0), b2, voffB);
            PG8_BAR; PG8_WAIT_L(0); PG8_MMA(0, 1, At, B1); PG8_BAR;
            PG8_LDA(At, 0, 1); PG8_STAGE(PG8_SA(0, 0), a2, v2[0]);
            PG8_BAR; PG8_WAIT_L(0); PG8_MMA(1, 0, At, B0); PG8_BAR; PG8_SCHED;
            PG8_STAGE(PG8_SB(0, 1), b2 + hstepB, voffB);
            PG8_WAIT_V(6); PG8_BAR; PG8_MMA(1, 1, At, B1); PG8_BAR;
            PG8_LDB(B0, 1, 0); PG8_SCHED; PG8_LDA(At, 1, 0); PG8_STAGE(PG8_SA(0, 1), a2, v2[1]);
            PG8_WAIT_L(8); PG8_BAR; PG8_WAIT_L(0); PG8_MMA(0, 0, At, B0); PG8_BAR; PG8_SCHED;
            PG8_LDB(B1, 1, 1); PG8_STAGE(PG8_SB(1, 0), b3, voffB);
            PG8_BAR; PG8_WAIT_L(0); PG8_MMA(0, 1, At, B1); PG8_BAR;
            PG8_LDA(At, 1, 1); PG8_STAGE(PG8_SA(1, 0), a3, v2[0]);
            PG8_BAR; PG8_WAIT_L(0); PG8_MMA(1, 0, At, B0); PG8_BAR; PG8_SCHED;
            PG8_STAGE(PG8_SB(1, 1), b3 + hstepB, voffB);
            PG8_WAIT_V(6); PG8_BAR; PG8_MMA(1, 1, At, B1); PG8_BAR;
        }
        E(acc, cur, wr, wc, fr, fq);
        if (!has_next) break;
#pragma unroll
        for (int a = 0; a < 2; ++a)
#pragma unroll
            for (int b = 0; b < 2; ++b)
#pragma unroll
                for (int m = 0; m < 4; ++m)
#pragma unroll
                    for (int n = 0; n < 2; ++n) acc[a][b][m][n] = (f32x4){0.f, 0.f, 0.f, 0.f};
        cur = nxt; cA = nA; cB = nB; ++ui;
        if (GATHER) {
#pragma unroll
            for (int h = 0; h < 2; ++h) { vA[h][0] = vN[h][0]; vA[h][1] = vN[h][1]; } }
        has_next = S.next(ui + 1, nxt);
        if (GATHER && has_next) { PG8_AOFF(vN, nxt); }
    }
    PG8_WAIT_V(0);
    if (wr == 0) PG8_BAR;
    PG8_BAR;
#undef PG8_AOFF
#undef PG8_SA
#undef PG8_SB
#undef PG8_STAGE
#undef PG8_LDA
#undef PG8_LDB
#undef PG8_MMA
#undef PG8_WAIT_V
#undef PG8_WAIT_L
#undef PG8_BAR
#undef PG8_SCHED
}
}
constexpr int NTHR = 512;
constexpr int LDS_BYTES = 147456;
constexpr int LDS_MISC = 131072;

struct Frame {
    LAS unsigned char* lds;
    int tid, lane, wave, G, bid;
    unsigned char* ws;
    const float* const* in;
};

enum { I_X = 0, I_C, I_CTX, I_CCTX, I_MODW, I_MODB, I_WIN, I_WOUT, I_MU, I_W0, I_WUP, I_A0, I_AUP, I_GUP, I_KK, I_KA, I_RK, I_GNG, I_GNB,
       I_QN, I_KVN, I_WUQ, I_WUKV, I_RGG, I_RGB, I_LN1G, I_LN1B, I_LN2G, I_LN2B, I_RTW, I_RTB, I_W1, I_W3, I_W2 };

__device__ __forceinline__ float wave_sum(float v) {
#pragma unroll
    for (int o = 32; o >= 1; o >>= 1) v += __shfl_xor(v, o);
    return v;
}

__device__ __forceinline__ void mod_phase(const Params& p, LAS unsigned char* lds, int bid, int G) {
    const int tid = tid_(), lane = tid & 63, wv = tid >> 6;
    LAS float* S = (LAS float*)lds;
    float* MOD = (float*)(p.ws + WS_MOD);
    for (int u = bid; u < DEPTH * 96; u += G) {
        const int l = u / 96, col0 = (u % 96) * 128;
        const float* W = p.in[I_MODW] + (size_t)l * DM * 12288;
        float acc[17][2];
#pragma unroll
        for (int r = 0; r < 17; ++r) { acc[r][0] = 0.f; acc[r][1] = 0.f; }
        for (int half = 0; half < 2; ++half) {
            __syncthreads();
            for (int idx = tid; idx < 17 * 1024; idx += NTHR) { const int r = idx >> 10, kk = idx & 1023, k = half * 1024 + kk;
                const float v = (r < 16) ? p.in[I_C][r * DM + k] : p.in[I_CCTX][k]; S[idx] = siluf_(v); }
            __syncthreads();
            for (int kk = wv * 128; kk < wv * 128 + 128; kk += 8) {
                f32x2 w[8];
#pragma unroll
                for (int j = 0; j < 8; ++j) w[j] = __builtin_nontemporal_load((const f32x2*)(W + (size_t)(half * 1024 + kk + j) * 12288 + col0 + 2 * lane));
#pragma unroll
                for (int q4 = 0; q4 < 2; ++q4)
#pragma unroll
                    for (int r = 0; r < 17; ++r) { const f32x4 s = *(const LAS f32x4*)(S + r * 1024 + kk + 4 * q4);
                        acc[r][0] += s[0] * w[4 * q4][0] + s[1] * w[4 * q4 + 1][0] + s[2] * w[4 * q4 + 2][0] + s[3] * w[4 * q4 + 3][0];
                        acc[r][1] += s[0] * w[4 * q4][1] + s[1] * w[4 * q4 + 1][1] + s[2] * w[4 * q4 + 2][1] + s[3] * w[4 * q4 + 3][1]; }
            }
        }
        __syncthreads();
#pragma unroll
        for (int r = 0; r < 17; ++r) { S[(wv * 17 + r) * 128 + 2 * lane] = acc[r][0]; S[(wv * 17 + r) * 128 + 2 * lane + 1] = acc[r][1]; }
        __syncthreads();
        for (int idx = tid; idx < 17 * 128; idx += NTHR) { const int r = idx >> 7, cc = idx & 127; float s = 0.f;
#pragma unroll
            for (int w8 = 0; w8 < 8; ++w8) s += S[(w8 * 17 + r) * 128 + cc];
            MOD[((size_t)l * 17 + r) * 12288 + col0 + cc] = s + p.in[I_MODB][l * 12288 + col0 + cc]; }
    }
    __syncthreads();
}

__device__ __forceinline__ void rope_tables(const Params& p, int bid, int G) {
    float* COS = (float*)(p.ws + WS_COS); float* SIN = (float*)(p.ws + WS_SIN);
    for (int idx = bid * NTHR + tid_(); idx < 2048 * 32; idx += G * NTHR) {
        const int pos = idx >> 5, i = idx & 31; const int row = pos >> 6, col = pos & 63;
        const float inv = powf(10000.0f, -(float)(i & 15) / 16.0f);
        const float ang = (float)(i < 16 ? row : col) * inv;
        COS[idx] = cosf(ang); SIN[idx] = sinf(ang);
    }
}

template <class F>
__device__ __forceinline__ void cvt_tiles(LAS unsigned char* lds, bf16_t* dst, int N, int K, F src4, int& ctr, int bid, int G) {
    LAS bf16_t* T = (LAS bf16_t*)lds;
    const int tid = tid_(), nk = K >> 6, nun = (N >> 7) * nk;
    int u0 = (bid - ctr) % G; if (u0 < 0) u0 += G;
    ctr = (ctr + nun) % G;
    for (int u = u0; u < nun; u += G) {
        const int n0 = (u / nk) << 7, k0 = (u % nk) << 6;
        f32x4 v[4];
#pragma unroll
        for (int j = 0; j < 4; ++j) { const int e = tid + NTHR * j; v[j] = src4(k0 + (e >> 5), n0 + (e & 31) * 4); }
        __syncthreads();
#pragma unroll
        for (int j = 0; j < 4; ++j) { const int e = tid + NTHR * j, kl = e >> 5, nl = (e & 31) * 4;
#pragma unroll
            for (int i = 0; i < 4; ++i) T[(nl + i) * 66 + kl] = f2bf(v[j][i]); }
        __syncthreads();
#pragma unroll
        for (int jj = 0; jj < 2; ++jj) { const int idx = tid + NTHR * jj, nl = idx >> 3, kc = (idx & 7) * 8; u32x4 w; const LAS unsigned* tp = (const LAS unsigned*)(T + nl * 66 + kc);
          w.x = tp[0]; w.y = tp[1]; w.z = tp[2]; w.w = tp[3]; *(u32x4*)(dst + (size_t)(n0 + nl) * K + k0 + kc) = w; }
    }
}

__device__ __forceinline__ int win_srccol(int n) {
    if (n < 1536) return n;
    if (n < 2048) return 1760 + (n - 1536);
    if (n < 2304) return 2272 + (n - 2048);
    if (n < 2560) { const int j = n - 2304, d = j & 63; return 2592 + (j & ~63) + (d >> 1) + 32 * (d & 1); }
    if (n < 2816) { const int j = n - 2560, d = j & 63; return 2848 + (j & ~63) + (d >> 1) + 32 * (d & 1); }
    if (n < 3328) return 3104 + (n - 2816);
    if (n < 3840) return 3616 + (n - 3328);
    if (n < 3904) return 1536 + (n - 3840);
    if (n < 3968) return 1600 + (n - 3904);
    if (n < 4064) return 1664 + (n - 3968);
    if (n < 4128) { const int d = n - 4064; return 2528 + (d >> 1) + 32 * (d & 1); }
    return -1;
}

__device__ __forceinline__ void convert_weights(const Params& p, LAS unsigned char* lds, int l, int bid, int G) {
    int ctr = 0;
    { const float* w = p.in[I_WIN] + (size_t)l * DM * IN_COLS;
      cvt_tiles(lds, (bf16_t*)(p.ws + WS_WIN), NPC, DM, [=](int k, int n) -> f32x4 {
          const float* r = w + (size_t)k * IN_COLS;
          const bool inter = (n >= 2304 && n < 2816) || n >= 4064;
          if (!inter) return *(const f32x4*)(r + win_srccol(n));
          f32x4 o;
#pragma unroll
          for (int i = 0; i < 4; ++i) { const int sc = win_srccol(n + i); o[i] = sc < 0 ? 0.0f : r[sc < 0 ? 0 : sc]; }
          return o; }, ctr, bid, G); }
    { const float* w = p.in[I_WOUT] + (size_t)l * DM * DM;
      cvt_tiles(lds, (bf16_t*)(p.ws + WS_WOUT), DM, DM, [=](int k, int n) -> f32x4 { return *(const f32x4*)(w + (size_t)k * DM + n); }, ctr, bid, G); }
    { const float* w = p.in[I_WUQ] + (size_t)l * 512 * 1536; const float* g = p.in[I_QN] + l * 512;
      cvt_tiles(lds, (bf16_t*)(p.ws + WS_WUQ), 1536, 512, [=](int k, int n) -> f32x4 { const int h = n / 192, d = n % 192; const float* r = w + (size_t)k * 1536 + h * 192; const float gk = g[k];
          if (d < 128) return *(const f32x4*)(r + d) * gk;
          f32x4 o;
#pragma unroll
          for (int i = 0; i < 4; ++i) { const int dd = d - 128 + i; o[i] = r[128 + (dd >> 1) + 32 * (dd & 1)] * gk; }
          return o; }, ctr, bid, G); }
    { const float* w = p.in[I_WUKV] + (size_t)l * 256 * 2048; const float* g = p.in[I_KVN] + l * 256;
      cvt_tiles(lds, (bf16_t*)(p.ws + WS_WUKV), 2048, 256, [=](int k, int n) -> f32x4 { return *(const f32x4*)(w + (size_t)k * 2048 + n) * g[k]; }, ctr, bid, G); }
    for (int e = 0; e < NEXP; ++e) {
        const float* w1 = p.in[I_W1] + ((size_t)l * NEXP + e) * DM * DEXP; const float* w3 = p.in[I_W3] + ((size_t)l * NEXP + e) * DM * DEXP;
        cvt_tiles(lds, (bf16_t*)(p.ws + WS_W13) + (size_t)e * 1024 * DM, 1024, DM, [=](int k, int n) -> f32x4 { const int j = (n >> 3) << 2;
            const float* r = ((n >> 2) & 1) ? w3 : w1; return *(const f32x4*)(r + (size_t)k * DEXP + j); }, ctr, bid, G);
    }
    for (int e = 0; e < NEXP; ++e) {
        const float* w2 = p.in[I_W2] + ((size_t)l * NEXP + e) * DEXP * DM;
        cvt_tiles(lds, (bf16_t*)(p.ws + WS_W2) + (size_t)e * DM * DEXP, DM, DEXP, [=](int k, int n) -> f32x4 { return *(const f32x4*)(w2 + (size_t)k * DM + n); }, ctr, bid, G);
    }
    __syncthreads();
    { bf16_t* WUP = (bf16_t*)(p.ws + WS_WUP); bf16_t* AUP = (bf16_t*)(p.ws + WS_AUP); bf16_t* GUP = (bf16_t*)(p.ws + WS_GUP);
      const float* wu = p.in[I_WUP] + (size_t)l * 2 * 32 * 512; const float* au = p.in[I_AUP] + (size_t)l * 2 * 32 * 512; const float* gu = p.in[I_GUP] + (size_t)l * 96 * 512;
      for (int idx = bid * NTHR + tid_(); idx < 2 * 512 * 32; idx += G * NTHR) { const int d = idx >> 14, c = (idx >> 5) & 511, r = idx & 31;
          WUP[idx] = f2bf(wu[((size_t)d * 32 + r) * 512 + c]); AUP[idx] = f2bf(au[((size_t)d * 32 + r) * 512 + c]); }
      for (int idx = bid * NTHR + tid_(); idx < 512 * 96; idx += G * NTHR) { const int c = idx / 96, r = idx % 96; GUP[idx] = f2bf(gu[(size_t)r * 512 + c]); }
    }
}
#define DPP_ADD(v, ctrl) ((v) + __builtin_bit_cast(float, __builtin_amdgcn_update_dpp(0, __builtin_bit_cast(int, (v)), (ctrl), 0xF, 0xF, true)))
__device__ __forceinline__ float row16_sum(float v) {
    v = DPP_ADD(v, 0xB1); v = DPP_ADD(v, 0x4E); v = DPP_ADD(v, 0x141); v = DPP_ADD(v, 0x140); return v;
}
__device__ __forceinline__ float red8(float v) {
    v = DPP_ADD(v, 0xB1); v = DPP_ADD(v, 0x4E); v = DPP_ADD(v, 0x141); return v;
}
__device__ __forceinline__ f32x2 red8x2(f32x2 v) {
    float a = v[0], b = v[1];
    a = DPP_ADD(a, 0xB1); b = DPP_ADD(b, 0xB1); a = DPP_ADD(a, 0x4E); b = DPP_ADD(b, 0x4E); a = DPP_ADD(a, 0x141); b = DPP_ADD(b, 0x141);
    return (f32x2){a, b};
}
__device__ __forceinline__ float rows4_sum(float v) {
    { auto r = __builtin_amdgcn_permlane16_swap(__float_as_uint(v), __float_as_uint(v), false, false); v = __uint_as_float(r[0]) + __uint_as_float(r[1]); }
    { auto r = __builtin_amdgcn_permlane32_swap(__float_as_uint(v), __float_as_uint(v), false, false); v = __uint_as_float(r[0]) + __uint_as_float(r[1]); }
    return v;
}
__device__ __forceinline__ float wsum(float v) {
    v = row16_sum(v);
    return __builtin_bit_cast(float, __builtin_amdgcn_readlane(__builtin_bit_cast(int, v), 0)) + __builtin_bit_cast(float, __builtin_amdgcn_readlane(__builtin_bit_cast(int, v), 16)) +
           __builtin_bit_cast(float, __builtin_amdgcn_readlane(__builtin_bit_cast(int, v), 32)) + __builtin_bit_cast(float, __builtin_amdgcn_readlane(__builtin_bit_cast(int, v), 48));
}

__device__ __forceinline__ f32x4 load_bf4(const bf16_t* src);
__device__ __forceinline__ f32x4 unpack_bf4(const u32x2 w) { f32x4 r; r[0] = __uint_as_float(w.x << 16); r[1] = __uint_as_float(w.x & 0xffff0000u); r[2] = __uint_as_float(w.y << 16); r[3] = __uint_as_float(w.y & 0xffff0000u); return r; }
__device__ __forceinline__ const float* xrow_in(const Params& p, int m) {
    const int b = m / LT, t = m % LT;
    if (t < LC) return p.in[I_CTX] + ((size_t)b * LC + t) * DM;
    return p.in[I_X] + ((size_t)b * LL + (t - LC)) * DM;
}
__device__ __forceinline__ f32x4 xs_load(const Params& p, int m, int l, int e) {
    if (l == 0) return *(const f32x4*)(xrow_in(p, m) + e);
    return load_bf4((const bf16_t*)(p.ws + WS_XB) + (size_t)m * DM + e);
}
__device__ __forceinline__ const float* mod_ptr(const Params& p, int l, int m, int which) {
    const int b = m / LT, t = m % LT; const int row = (t < LC) ? 16 : b;
    return (const float*)(p.ws + WS_MOD) + ((size_t)l * 17 + row) * 12288 + which * DM;
}
__device__ __forceinline__ void store_bf4(bf16_t* dst, const f32x4 v) { u32x2 w; w.x = cvt_pk_bf16(v[0], v[1]); w.y = cvt_pk_bf16(v[2], v[3]); *(u32x2*)dst = w; }
__device__ __forceinline__ f32x4 load_bf4(const bf16_t* src) { const u32x2 w = *(const u32x2*)src; f32x4 r; r[0] = __uint_as_float(w.x << 16); r[1] = __uint_as_float(w.x & 0xffff0000u);
    r[2] = __uint_as_float(w.y << 16); r[3] = __uint_as_float(w.y & 0xffff0000u); return r; }

__device__ __forceinline__ f32x4 load_bf4_lds(const LAS bf16_t* src) { const u32x2 w = *(const LAS u32x2*)src; f32x4 r; r[0] = __uint_as_float(w.x << 16); r[1] = __uint_as_float(w.x & 0xffff0000u);
    r[2] = __uint_as_float(w.y << 16); r[3] = __uint_as_float(w.y & 0xffff0000u); return r; }
__device__ __forceinline__ void modulate_phase(const Params& p, int l, int bid, int G) {
    const int tid = tid_(), lane = tid & 63, wv = tid >> 6;
    bf16_t* ACT = (bf16_t*)(p.ws + WS_ACT);
    for (int m = bid * 8 + wv; m < MT; m += G * 8) {
        const float* x = xrow_in(p, m); const float* sh = mod_ptr(p, l, m, 0); const float* sc = mod_ptr(p, l, m, 1);
#pragma unroll
        for (int j = 0; j < 8; ++j) { const int e = j * 256 + lane * 4;
            const f32x4 xv = *(const f32x4*)(x + e), s = *(const f32x4*)(sc + e), h = *(const f32x4*)(sh + e);
            store_bf4(ACT + (size_t)m * DM + e, xv * (1.0f + s) + h); }
    }
}

__device__ __forceinline__ void moe_prefix(const Params& p, LAS unsigned char* lds, int l) {
    LAS int* toff = (LAS int*)(lds + LDS_MISC + 64);
    const int tid = tid_();
    __syncthreads();
    if (tid < 64) {
        const unsigned* cnt = (const unsigned*)(p.ws + WS_CTL) + CW_CNT + l * 16 * 64;
        const unsigned c = (tid < NEXP) ? __hip_atomic_load(cnt + tid * 64, __ATOMIC_RELAXED, __HIP_MEMORY_SCOPE_AGENT) : 0u;
        const int tiles = (int)((c + 255u) >> 8); int s = 0;
#pragma unroll
        for (int e = 0; e < NEXP; ++e) { const int te = __builtin_amdgcn_readlane(tiles, e); if (tid == e) toff[e] = s; s += te; }
        if (tid == 0) toff[16] = s;
    }
    __syncthreads();
}

struct RowSel { int e0, e1; float w0, w1; };
__device__ __forceinline__ RowSel route_row(const float (&lgt)[16], const float* __restrict__ rtb) {
    float sg[16], sb[16];
#pragma unroll
    for (int e16 = 0; e16 < 16; ++e16) { sg[e16] = sigmoidf_(lgt[e16]); sb[e16] = sg[e16] + rtb[e16]; }
    int best = 0; float bestv = -1e30f;
#pragma unroll
    for (int g = 0; g < 4; ++g) { const float a = sb[4 * g], b = sb[4 * g + 1], c = sb[4 * g + 2], d = sb[4 * g + 3];
        const float hi1 = fmaxf(a, b), lo1 = fminf(a, b), hi2 = fmaxf(c, d), lo2 = fminf(c, d);
        const float top = fmaxf(hi1, hi2), second = fmaxf(fminf(hi1, hi2), hi1 >= hi2 ? lo1 : lo2);
        const float gs = top + second; if (gs > bestv) { bestv = gs; best = g; } }
    float gb[4], gsv[4];
#pragma unroll
    for (int i = 0; i < 4; ++i) { gb[i] = 0.f; gsv[i] = 0.f; }
#pragma unroll
    for (int g = 0; g < 4; ++g) if (g == best) {
#pragma unroll
        for (int i = 0; i < 4; ++i) { gb[i] = sb[4 * g + i]; gsv[i] = sg[4 * g + i]; } }
    int i0 = 0; float b0 = gb[0];
#pragma unroll
    for (int i = 1; i < 4; ++i) if (gb[i] > b0) { b0 = gb[i]; i0 = i; }
    int i1 = -1; float b1 = -1e30f;
#pragma unroll
    for (int i = 0; i < 4; ++i) if (i != i0 && gb[i] > b1) { b1 = gb[i]; i1 = i; }
    float s0 = 0.f, s1 = 0.f;
#pragma unroll
    for (int i = 0; i < 4; ++i) { if (i == i0) s0 = gsv[i]; if (i == i1) s1 = gsv[i]; }
    const float inv = 2.5f / (s0 + s1);
    RowSel r; r.e0 = best * 4 + i0; r.e1 = best * 4 + i1; r.w0 = s0 * inv; r.w1 = s1 * inv; return r;
}
__device__ __forceinline__ float sum4(const f32x4 v) { return (v[0] + v[1]) + (v[2] + v[3]); }
__device__ __forceinline__ float sq4(const f32x4 v) { return (v[0] * v[0] + v[1] * v[1]) + (v[2] * v[2] + v[3] * v[3]); }

template <int MODE>
__device__ __forceinline__ void ln1_phase(const Params& p, LAS unsigned char* lds, int l, int bid, int G) {
    const int tid = tid_(), lane = tid & 63, wv = __builtin_amdgcn_readfirstlane(tid >> 6);
    LAS float* RW = (LAS float*)lds;
    __syncthreads();
    { f32x4 t[16];
#pragma unroll
      for (int j = 0; j < 16; ++j) t[j] = ((const f32x4*)p.in[I_RTW])[tid + NTHR * j];
#pragma unroll
      for (int j = 0; j < 16; ++j) { const int i = tid + NTHR * j, d = i >> 2, c = i & 3, dp = (d & 3) * 512 + (d >> 2);
          ((LAS f32x4*)RW)[dp * 4 + ((c + (dp >> 2)) & 3)] = t[j]; } }
    __syncthreads();
    int po[4];
#pragma unroll
    for (int c = 0; c < 4; ++c) po[c] = (c + (lane >> 2)) & 3;
    bf16_t* ACT = (bf16_t*)(p.ws + WS_ACT); const bf16_t* MO = (const bf16_t*)(p.ws + WS_MO); bf16_t* XB = (bf16_t*)(p.ws + WS_XB);
    int* LIST = (int*)(p.ws + WS_LIST); int* TINF = (int*)(p.ws + WS_TINF);
    unsigned* cnt = (unsigned*)(p.ws + WS_CTL) + CW_CNT + l * 16 * 64;
    LAS unsigned* lcnt = (LAS unsigned*)(lds + LDS_MISC + 256);
    LAS int* rinfo = (LAS int*)(lds + LDS_MISC + 1024);
    if (tid < 32) lcnt[tid] = 0u;
    __syncthreads();
    int nrow = 0;
    const float* lg = p.in[I_LN1G] + l * DM; const float* lb = p.in[I_LN1B] + l * DM; const float* rtb = p.in[I_RTB];
    const int rpw = (((MT + G - 1) / G) + 1) & ~1, rbase = bid * rpw;
    for (int ri_ = 2 * wv; ri_ < rpw; ri_ += 16) {
        const int m = rbase + ri_; if (m >= MT) break;
        if (l == DEPTH - 1 && (m % LT) < LC) continue;
        const float* g1 = mod_ptr(p, l, m, 2); const float* sh2 = mod_ptr(p, l, m, 3); const float* sc2 = mod_ptr(p, l, m, 4);
        u32x2 v0[8], v1[8]; float s0_ = 0.f, s1_ = 0.f, q0 = 0.f, q1 = 0.f;
#pragma unroll
        for (int jh = 0; jh < 2; ++jh) { u32x2 moa[4], mob[4], xa_[4], xb_[4];
#pragma unroll
          for (int jj = 0; jj < 4; ++jj) { const int e = (jh * 4 + jj) * 256 + lane * 4; moa[jj] = *(const u32x2*)(MO + (size_t)m * DM + e); mob[jj] = *(const u32x2*)(MO + (size_t)(m + 1) * DM + e);
              xa_[jj] = (l > 0) ? *(const u32x2*)(XB + (size_t)m * DM + e) : (u32x2){0u, 0u}; xb_[jj] = (l > 0) ? *(const u32x2*)(XB + (size_t)(m + 1) * DM + e) : (u32x2){0u, 0u}; }
#pragma unroll
          for (int jj = 0; jj < 4; ++jj) { const int j = jh * 4 + jj, e = j * 256 + lane * 4; const f32x4 gt = *(const f32x4*)(g1 + e);
            const f32x4 xa = (l > 0) ? unpack_bf4(xa_[jj]) : *(const f32x4*)(xrow_in(p, m) + e), xb = (l > 0) ? unpack_bf4(xb_[jj]) : *(const f32x4*)(xrow_in(p, m + 1) + e);
            const f32x4 va = ALPHA_F * xa + gt * unpack_bf4(moa[jj]), vb = ALPHA_F * xb + gt * unpack_bf4(mob[jj]);
            s0_ += sum4(va); s1_ += sum4(vb); q0 += sq4(va); q1 += sq4(vb);
            v0[j] = (u32x2){cvt_pk_bf16(va[0], va[1]), cvt_pk_bf16(va[2], va[3])}; v1[j] = (u32x2){cvt_pk_bf16(vb[0], vb[1]), cvt_pk_bf16(vb[2], vb[3])}; }
          __builtin_amdgcn_sched_barrier(0); }
        const float mean0 = wsum(s0_) * (1.0f / DM), mean1 = wsum(s1_) * (1.0f / DM);
        const float rstd0 = rsqrtf(fmaxf(wsum(q0) * (1.0f / DM) - mean0 * mean0, 0.f) + LN_EPS_F), rstd1 = rsqrtf(fmaxf(wsum(q1) * (1.0f / DM) - mean1 * mean1, 0.f) + LN_EPS_F);
        float lgt0[16], lgt1[16];
#pragma unroll
        for (int e16 = 0; e16 < 16; ++e16) { lgt0[e16] = 0.f; lgt1[e16] = 0.f; }
#pragma unroll
        for (int j = 0; j < 8; ++j) { const int e = j * 256 + lane * 4;
            const f32x4 gg = *(const f32x4*)(lg + e), bb = *(const f32x4*)(lb + e), sc = *(const f32x4*)(sc2 + e), sh = *(const f32x4*)(sh2 + e);
            const f32x4 xa = (unpack_bf4(v0[j]) - mean0) * rstd0 * gg + bb, xb = (unpack_bf4(v1[j]) - mean1) * rstd1 * gg + bb;
            if (MODE == 0) { store_bf4(XB + (size_t)m * DM + e, xa); store_bf4(XB + (size_t)(m + 1) * DM + e, xb); }
            const f32x4 ua = xa * (1.0f + sc) + sh, ub = xb * (1.0f + sc) + sh;
            if (MODE == 0) { store_bf4(ACT + (size_t)m * DM + e, ua); store_bf4(ACT + (size_t)(m + 1) * DM + e, ub); }
#pragma unroll
            for (int i = 0; i < 4; ++i) {
                const LAS f32x4* rw = (const LAS f32x4*)(RW + (i * 512 + j * 64 + lane) * 16);
                const f32x4 r0 = rw[po[0]], r1 = rw[po[1]], r2 = rw[po[2]], r3 = rw[po[3]];
#pragma unroll
                for (int c = 0; c < 4; ++c) { lgt0[c] += ua[i] * r0[c]; lgt0[4 + c] += ua[i] * r1[c]; lgt0[8 + c] += ua[i] * r2[c]; lgt0[12 + c] += ua[i] * r3[c];
                                              lgt1[c] += ub[i] * r0[c]; lgt1[4 + c] += ub[i] * r1[c]; lgt1[8 + c] += ub[i] * r2[c]; lgt1[12 + c] += ub[i] * r3[c]; }
            }
            __builtin_amdgcn_sched_barrier(0);
        }
#pragma unroll
        for (int e16 = 0; e16 < 16; ++e16) lgt0[e16] = wsum(lgt0[e16]);
        const RowSel ra = route_row(lgt0, rtb);
        __builtin_amdgcn_sched_barrier(0);
#pragma unroll
        for (int e16 = 0; e16 < 16; ++e16) lgt1[e16] = wsum(lgt1[e16]);
        const RowSel rb = route_row(lgt1, rtb);
        if (MODE != 0) { asm volatile("" :: "v"(ra.e0), "v"(ra.e1), "v"(ra.w0), "v"(ra.w1), "v"(rb.e0), "v"(rb.e1), "v"(rb.w0), "v"(rb.w1)); }
        if (MODE == 0 && lane == 0) {
            { const unsigned r0 = __hip_atomic_fetch_add(lcnt + ra.e0, 1u, __ATOMIC_RELAXED, __HIP_MEMORY_SCOPE_WORKGROUP), r1 = __hip_atomic_fetch_add(lcnt + ra.e1, 1u, __ATOMIC_RELAXED, __HIP_MEMORY_SCOPE_WORKGROUP);
              LAS int* ri = rinfo + (wv * 64 + nrow) * 4; ri[0] = ra.e0; ri[1] = (int)r0; ri[2] = ra.e1; ri[3] = (int)r1;
              int* ti = TINF + (size_t)m * 8; ti[0] = ra.e0; ti[2] = ra.e1; ti[4] = __float_as_int(ra.w0); ti[5] = __float_as_int(ra.w1); }
            { const unsigned r0 = __hip_atomic_fetch_add(lcnt + rb.e0, 1u, __ATOMIC_RELAXED, __HIP_MEMORY_SCOPE_WORKGROUP), r1 = __hip_atomic_fetch_add(lcnt + rb.e1, 1u, __ATOMIC_RELAXED, __HIP_MEMORY_SCOPE_WORKGROUP);
              LAS int* ri = rinfo + (wv * 64 + nrow + 1) * 4; ri[0] = rb.e0; ri[1] = (int)r0; ri[2] = rb.e1; ri[3] = (int)r1;
              int* ti = TINF + (size_t)(m + 1) * 8; ti[0] = rb.e0; ti[2] = rb.e1; ti[4] = __float_as_int(rb.w0); ti[5] = __float_as_int(rb.w1); }
        }
        nrow += 2;
    }
    __syncthreads();
    if (MODE != 0) return;
    if (tid < NEXP) lcnt[16 + tid] = __hip_atomic_fetch_add(cnt + tid * 64, lcnt[tid], __ATOMIC_RELAXED, __HIP_MEMORY_SCOPE_AGENT);
    __syncthreads();
    { int k = 0;
      for (int ri_ = 2 * wv; ri_ < rpw; ri_ += 16) {
        const int m0_ = rbase + ri_; if (m0_ >= MT) break;
        if (l == DEPTH - 1 && (m0_ % LT) < LC) continue;
#pragma unroll
        for (int q = 0; q < 2; ++q) { const int m = m0_ + q;
          if (lane == (k & 63)) { const LAS int* ri = rinfo + (wv * 64 + k) * 4; const int e0 = ri[0], e1 = ri[2];
            const int s0_ = (int)lcnt[16 + e0] + ri[1], s1_ = (int)lcnt[16 + e1] + ri[3];
            int* ti = TINF + (size_t)m * 8; ti[1] = s0_; ti[3] = s1_; LIST[(size_t)e0 * MT + s0_] = m; LIST[(size_t)e1 * MT + s1_] = m; }
          ++k; } } }
    __syncthreads();
}

template <int MODE>
__device__ __forceinline__ void ln2_phase(const Params& p, LAS unsigned char* lds, int l, int bid, int G) {
    const int tid = tid_(), lane = tid & 63, wv = tid >> 6;
    moe_prefix(p, lds, l);
    const LAS int* toff = (const LAS int*)(lds + LDS_MISC + 64);
    bf16_t* ACT = (bf16_t*)(p.ws + WS_ACT); const bf16_t* Y = (const bf16_t*)(p.ws + WS_Y); const int* TINF = (const int*)(p.ws + WS_TINF); bf16_t* XB = (bf16_t*)(p.ws + WS_XB);
    const float* lg = p.in[I_LN2G] + l * DM; const float* lb = p.in[I_LN2B] + l * DM;
    const int rpw = (((MT + G - 1) / G) + 1) & ~1, rbase = bid * rpw;
    for (int pi = wv; 2 * pi < rpw; pi += 8) {
        const int m = rbase + 2 * pi; if (m >= MT) break;
        if (l == DEPTH - 1 && (m % LT) < LC) continue;
        const float* g2 = mod_ptr(p, l, m, 5);
        float* xf = p.out + ((size_t)(m / LT) * LL + ((m % LT) - LC)) * DM;
        const int* ti = TINF + (size_t)m * 8;
        const int ea0 = ti[0], sa0 = ti[1], ea1 = ti[2], sa1 = ti[3]; const float wa0 = __int_as_float(ti[4]), wa1 = __int_as_float(ti[5]);
        const int eb0 = ti[8], sb0 = ti[9], eb1 = ti[10], sb1 = ti[11]; const float wb0 = __int_as_float(ti[12]), wb1 = __int_as_float(ti[13]);
        const bf16_t* ya0 = Y + ((size_t)toff[ea0] * 256 + sa0) * DM; const bf16_t* ya1 = Y + ((size_t)toff[ea1] * 256 + sa1) * DM;
        const bf16_t* yb0 = Y + ((size_t)toff[eb0] * 256 + sb0) * DM; const bf16_t* yb1 = Y + ((size_t)toff[eb1] * 256 + sb1) * DM;
        f32x4 va[8], vb[8]; float sa_ = 0.f, sb_ = 0.f;
#pragma unroll
        for (int j = 0; j < 8; ++j) { const int e = j * 256 + lane * 4; const f32x4 g = *(const f32x4*)(g2 + e);
            va[j] = ALPHA_F * load_bf4(XB + (size_t)m * DM + e) + g * (wa0 * load_bf4(ya0 + e) + wa1 * load_bf4(ya1 + e));
            vb[j] = ALPHA_F * load_bf4(XB + (size_t)(m + 1) * DM + e) + g * (wb0 * load_bf4(yb0 + e) + wb1 * load_bf4(yb1 + e));
            sa_ += sum4(va[j]); sb_ += sum4(vb[j]); }
        const float meana = wsum(sa_) * (1.0f / DM), meanb = wsum(sb_) * (1.0f / DM); float qa = 0.f, qb = 0.f;
#pragma unroll
        for (int j = 0; j < 8; ++j) { va[j] = va[j] - meana; vb[j] = vb[j] - meanb; qa += sq4(va[j]); qb += sq4(vb[j]); }
        const float rstda = rsqrtf(wsum(qa) * (1.0f / DM) + LN_EPS_F), rstdb = rsqrtf(wsum(qb) * (1.0f / DM) + LN_EPS_F);
        const float* sh = (l + 1 < DEPTH) ? mod_ptr(p, l + 1, m, 0) : nullptr; const float* sc = (l + 1 < DEPTH) ? mod_ptr(p, l + 1, m, 1) : nullptr;
#pragma unroll
        for (int j = 0; j < 8; ++j) { const int e = j * 256 + lane * 4;
            const f32x4 gg = *(const f32x4*)(lg + e), bb = *(const f32x4*)(lb + e);
            const f32x4 xa = va[j] * rstda * gg + bb, xb = vb[j] * rstdb * gg + bb;
            if (MODE != 0) { asm volatile("" :: "v"(xa), "v"(xb)); }
            else if (l + 1 < DEPTH) { const f32x4 s1 = 1.0f + *(const f32x4*)(sc + e), h1 = *(const f32x4*)(sh + e);
                store_bf4(XB + (size_t)m * DM + e, xa); store_bf4(XB + (size_t)(m + 1) * DM + e, xb);
                store_bf4(ACT + (size_t)m * DM + e, xa * s1 + h1); store_bf4(ACT + (size_t)(m + 1) * DM + e, xb * s1 + h1); }
            else { *(f32x4*)(xf + e) = xa; *(f32x4*)(xf + DM + e) = xb; } }
    }
}
template <int MODE>
__device__ __forceinline__ void prep_phase(const Params& p, LAS unsigned char* lds, int l, int bid, int G) {
    const int tid0 = tid_(), lane = tid0 & 63, wv = __builtin_amdgcn_readfirstlane(tid0 >> 6);
    constexpr int RW_P = 1768;
    LAS bf16_t* RAW = (LAS bf16_t*)lds;
    LAS bf16_t* ACTW = (LAS bf16_t*)(lds + 65536);
    LAS bf16_t* ACTA = (LAS bf16_t*)(lds + 65536 + 2048);
    LAS bf16_t* ACTG = (LAS bf16_t*)(lds + 65536 + 4096);
    const bf16_t* P = (const bf16_t*)(p.ws + WS_P);
    bf16_t* OPS = (bf16_t*)(p.ws + WS_OPS); bf16_t* Gb = (bf16_t*)(p.ws + WS_G); float* BON = (float*)(p.ws + WS_BON);
    bf16_t* VSH = (bf16_t*)(p.ws + WS_VSH);
    float* RSQ = (float*)(p.ws + WS_RSQ); float* RSKV = (float*)(p.ws + WS_RSKV);
    bf16_t* KR = (bf16_t*)(p.ws + WS_KR); bf16_t* RQ = (bf16_t*)(p.ws + WS_RQ); bf16_t* RK = (bf16_t*)(p.ws + WS_RK);
    const float* COS = (const float*)(p.ws + WS_COS); const float* SIN = (const float*)(p.ws + WS_SIN);
    const float* mu = p.in[I_MU] + l * 1760;
    const bf16_t* WUP = (const bf16_t*)(p.ws + WS_WUP); const bf16_t* AUP = (const bf16_t*)(p.ws + WS_AUP); const bf16_t* GUP = (const bf16_t*)(p.ws + WS_GUP);
    const float* w0 = p.in[I_W0] + l * 1024; const float* a0 = p.in[I_A0] + l * 1024;
    const float* kkp = p.in[I_KK] + l * 512; const float* kap = p.in[I_KA] + l * 512; const float* rkp = p.in[I_RK] + l * 512;
    for (int unit = bid; unit < MT / 16; unit += G) {
        const int tid = tid_();
        const int m0 = unit * 16, t0 = m0 % LT; const bool isctx = t0 < LC; const int seg_lo = isctx ? 0 : LC, seg_hi = isctx ? LC : LT;
        __syncthreads();
        { bf16x8 tmp[8];
#pragma unroll
          for (int j = 0; j < 8; ++j) { const int item = tid + NTHR * j, rr = item / 220, cc = item % 220; const int t = t0 - 1 + rr;
              const int pc = cc < 192 ? cc * 8 : PC_WD + (cc - 192) * 8;
              bf16x8 z;
#pragma unroll
              for (int i = 0; i < 8; ++i) z[i] = 0;
              tmp[j] = (item < 18 * 220 && t >= seg_lo && t < seg_hi) ? *(const bf16x8*)(P + ((size_t)m0 - 1 + rr) * NPC + pc) : z; }
#pragma unroll
          for (int j = 0; j < 8; ++j) { const int item = tid + NTHR * j, rr = item / 220, cc = item % 220;
              if (item < 18 * 220) *(LAS bf16x8*)(RAW + rr * RW_P + cc * 8) = tmp[j]; } }
        { bf16x8 cq_[2], ck_[2]; unsigned kw_, rw_[4]; float kc_ = 1.f, ks_ = 0.f, rc_[4], rs_[4];
#pragma unroll
          for (int tt = 0; tt < 2; ++tt) { const size_t m = (size_t)m0 + wv * 2 + tt; cq_[tt] = *(const bf16x8*)(P + m * NPC + PC_CQ + lane * 8); ck_[tt] = *(const bf16x8*)(P + m * NPC + PC_CKV + (lane & 31) * 8); }
          { const int tok = tid >> 5, pi = tid & 31; const size_t m = (size_t)m0 + tok; kw_ = *(const unsigned*)(P + m * NPC + PC_KR + 2 * pi);
            if (!isctx) { const int pos = t0 + tok - LC; kc_ = COS[pos * 32 + pi]; ks_ = SIN[pos * 32 + pi]; } }
#pragma unroll
          for (int tt = 0; tt < 2; ++tt) { const size_t m = (size_t)m0 + wv * 2 + tt; float a[8]; float ss = 0.f, s2 = 0.f;
              unpack8(cq_[tt], a);
#pragma unroll
              for (int i = 0; i < 8; ++i) ss += a[i] * a[i];
              unpack8(ck_[tt], a);
#pragma unroll
              for (int i = 0; i < 8; ++i) s2 += (lane < 32) ? a[i] * a[i] : 0.f;
              ss = wsum(ss); s2 = wsum(s2);
              if (lane == 0) { RSQ[m] = rsqrtf(ss * (1.0f / 512.0f) + LN_EPS_F); RSKV[m] = rsqrtf(s2 * (1.0f / 256.0f) + LN_EPS_F); } }
          { const int tok = tid >> 5, pi = tid & 31; const size_t m = (size_t)m0 + tok; const float x1 = __uint_as_float(kw_ << 16), x2 = __uint_as_float(kw_ & 0xffff0000u);
            *(unsigned*)(KR + m * 64 + 2 * pi) = cvt_pk_bf16(x1 * kc_ - x2 * ks_, x1 * ks_ + x2 * kc_); }
#pragma unroll 1
          for (int jh = 0; jh < 2; ++jh) {
#pragma unroll
            for (int j = 0; j < 4; ++j) { const int item = tid + NTHR * (jh * 4 + j), tok = item >> 8, rem = item & 255, isk = rem >> 7, pr = rem & 127, pi = pr & 31; const size_t m = (size_t)m0 + tok;
                rw_[j] = *(const unsigned*)(P + m * NPC + (isk ? PC_RK : PC_RQ) + 2 * pr); rc_[j] = 1.f; rs_[j] = 0.f;
                if (!isctx) { const int pos = t0 + tok - LC; rc_[j] = COS[pos * 32 + pi]; rs_[j] = SIN[pos * 32 + pi]; } }
#pragma unroll
            for (int j = 0; j < 4; ++j) { const int item = tid + NTHR * (jh * 4 + j), tok = item >> 8, rem = item & 255, isk = rem >> 7, pr = rem & 127; const size_t m = (size_t)m0 + tok;
                const float x1 = __uint_as_float(rw_[j] << 16), x2 = __uint_as_float(rw_[j] & 0xffff0000u), sc_ = isk ? 0.125f : 1.0f;
                *(unsigned*)((isk ? RK : RQ) + m * 256 + 2 * pr) = cvt_pk_bf16((x1 * rc_[j] - x2 * rs_[j]) * sc_, (x1 * rs_[j] + x2 * rc_[j]) * sc_); } } }
        __syncthreads();
        if (tid < 448) { const int tok = tid / 28, c8 = tid % 28; float a[8], bl[8], br[8], o[8];
            unpack8(*(const LAS bf16x8*)(RAW + (tok + 1) * RW_P + 1536 + c8 * 8), a); unpack8(*(const LAS bf16x8*)(RAW + tok * RW_P + 1536 + c8 * 8), bl); unpack8(*(const LAS bf16x8*)(RAW + (tok + 2) * RW_P + 1536 + c8 * 8), br);
#pragma unroll
            for (int i = 0; i < 8; ++i) { const float s = a[i] + (0.5f * (bl[i] + br[i]) - a[i]) * mu[1536 + c8 * 8 + i];
                o[i] = (c8 < 8) ? (1.0f - 2.0f * __builtin_amdgcn_rcpf(1.0f + __expf(2.0f * s))) : ((c8 < 16) ? s : sigmoidf_(s)); }
            const bf16x8 pk = pack8(o);
            if (c8 < 8) { const int jj = c8 * 8; *(LAS bf16x8*)(ACTW + ((jj >> 5) * 16 + tok) * 32 + (jj & 31)) = pk; }
            else if (c8 < 16) { const int jj = (c8 - 8) * 8; *(LAS bf16x8*)(ACTA + ((jj >> 5) * 16 + tok) * 32 + (jj & 31)) = pk; }
            else { const int jj = (c8 - 16) * 8; *(LAS bf16x8*)(ACTG + tok * 96 + jj) = pk; }
        }
        __syncthreads();
        if (MODE == 2) continue;
        {
            const int h = wv, tok = lane & 15, g = lane >> 4; const size_t m = (size_t)m0 + tok;
            const int cb = h * 64 + 16 * g;
            const int wrow = h * 64 + 16 * ((lane & 15) >> 2) + (lane & 3);
            bf16_t* ops = OPS + (m * 8 + h) * OPS_HW + 16 * g;
            float* opw = (float*)(OPS + (m * 8 + h) * OPS_HW) + 16 * g;
#define PREP_SH16(dst, col) do { float c_[16], l_[16], r_[16]; \
                unpack8(*(const LAS bf16x8*)(RAW + (tok + 1) * RW_P + (col)), *(float(*)[8])&c_[0]); unpack8(*(const LAS bf16x8*)(RAW + (tok + 1) * RW_P + (col) + 8), *(float(*)[8])&c_[8]); \
                unpack8(*(const LAS bf16x8*)(RAW + tok * RW_P + (col)), *(float(*)[8])&l_[0]); unpack8(*(const LAS bf16x8*)(RAW + tok * RW_P + (col) + 8), *(float(*)[8])&l_[8]); \
                unpack8(*(const LAS bf16x8*)(RAW + (tok + 2) * RW_P + (col)), *(float(*)[8])&r_[0]); unpack8(*(const LAS bf16x8*)(RAW + (tok + 2) * RW_P + (col) + 8), *(float(*)[8])&r_[8]); \
                _Pragma("unroll") for (int i4 = 0; i4 < 4; ++i4) { const f32x4 m_ = *(const f32x4*)(mu + (col) + 4 * i4); \
                    _Pragma("unroll") for (int i = 0; i < 4; ++i) { const int ii = 4 * i4 + i; dst[ii] = c_[ii] + (0.5f * (l_[ii] + r_[ii]) - c_[ii]) * m_[i]; } } } while (0)
#define PREP_ST16(ptr, v) do { *(bf16x8*)(ptr) = pack8(*(const float(*)[8])&(v)[0]); *(bf16x8*)((ptr) + 8) = pack8(*(const float(*)[8])&(v)[8]); } while (0)
#define PREP_LD16(dst, src) do { _Pragma("unroll") for (int i4 = 0; i4 < 4; ++i4) { const f32x4 t_ = *(const f32x4*)((src) + 4 * i4); dst[4 * i4] = t_[0]; dst[4 * i4 + 1] = t_[1]; dst[4 * i4 + 2] = t_[2]; dst[4 * i4 + 3] = t_[3]; } } while (0)
            const f32x4 z4 = {0.f, 0.f, 0.f, 0.f};
            { const bf16x8 bw0 = *(const LAS bf16x8*)(ACTW + (0 * 16 + tok) * 32 + 8 * g), bw1 = *(const LAS bf16x8*)(ACTW + (1 * 16 + tok) * 32 + 8 * g);
              float zf[16], zb[16], w0f[16], w0b[16]; PREP_LD16(w0f, w0 + cb); PREP_LD16(w0b, w0 + 512 + cb);
#pragma unroll
              for (int ct = 0; ct < 4; ++ct) {
                  const f32x4 a = __builtin_amdgcn_mfma_f32_16x16x32_bf16(*(const bf16x8*)(WUP + ((size_t)0 * 512 + wrow + 4 * ct) * 32 + 8 * g), bw0, z4, 0, 0, 0);
                  const f32x4 c = __builtin_amdgcn_mfma_f32_16x16x32_bf16(*(const bf16x8*)(WUP + ((size_t)1 * 512 + wrow + 4 * ct) * 32 + 8 * g), bw1, z4, 0, 0, 0);
#pragma unroll
                  for (int i = 0; i < 4; ++i) { zf[4 * ct + i] = a[i] + w0f[4 * ct + i]; zb[4 * ct + i] = c[i] + w0b[4 * ct + i]; } }
#pragma unroll
              for (int i = 0; i < 16; ++i) { zf[i] = __expf(-0.6065306597126334f * sigmoidf_(zf[i])); zb[i] = __expf(-0.6065306597126334f * sigmoidf_(zb[i])); }
              if (MODE == 0) {
#pragma unroll
                  for (int i4 = 0; i4 < 4; ++i4) { *(f32x4*)(opw + 4 * i4) = (f32x4){zf[4 * i4], zf[4 * i4 + 1], zf[4 * i4 + 2], zf[4 * i4 + 3]};
                                                   *(f32x4*)(opw + 128 + 4 * i4) = (f32x4){zb[4 * i4], zb[4 * i4 + 1], zb[4 * i4 + 2], zb[4 * i4 + 3]}; } }
              else asm volatile("" :: "v"(zf[0]), "v"(zb[0])); }
            float bon = 0.f;
            { const bf16x8 ba0 = *(const LAS bf16x8*)(ACTA + (0 * 16 + tok) * 32 + 8 * g), ba1 = *(const LAS bf16x8*)(ACTA + (1 * 16 + tok) * 32 + 8 * g);
              float af[16], ab[16]; PREP_LD16(af, a0 + cb); PREP_LD16(ab, a0 + 512 + cb);
#pragma unroll
              for (int ct = 0; ct < 4; ++ct) {
                  const f32x4 a = __builtin_amdgcn_mfma_f32_16x16x32_bf16(*(const bf16x8*)(AUP + ((size_t)0 * 512 + wrow + 4 * ct) * 32 + 8 * g), ba0, z4, 0, 0, 0);
                  const f32x4 c = __builtin_amdgcn_mfma_f32_16x16x32_bf16(*(const bf16x8*)(AUP + ((size_t)1 * 512 + wrow + 4 * ct) * 32 + 8 * g), ba1, z4, 0, 0, 0);
#pragma unroll
                  for (int i = 0; i < 4; ++i) { af[4 * ct + i] = sigmoidf_(af[4 * ct + i] + a[i]); ab[4 * ct + i] = sigmoidf_(ab[4 * ct + i] + c[i]); } }
              float kv[16]; PREP_SH16(kv, 512 + cb);
              float rr[16]; PREP_SH16(rr, cb);
              if (MODE == 0) PREP_ST16(ops + 576, rr); else asm volatile("" :: "v"(rr[0]));
              float ss = 0.f;
#pragma unroll
              for (int i4 = 0; i4 < 4; ++i4) { const f32x4 kk4 = *(const f32x4*)(kkp + cb + 4 * i4);
#pragma unroll
                  for (int i = 0; i < 4; ++i) { const float t = kv[4 * i4 + i] * kk4[i]; ss += t * t; } }
              ss = rows4_sum(ss); const float inv = rsqrtf(ss + 1e-12f);
              unsigned pf[16], pb[16], pnk[8];
#pragma unroll
              for (int i4 = 0; i4 < 4; ++i4) { const f32x4 kk4 = *(const f32x4*)(kkp + cb + 4 * i4), ka4 = *(const f32x4*)(kap + cb + 4 * i4), rk4 = *(const f32x4*)(rkp + cb + 4 * i4);
                  float vnk[4];
#pragma unroll
                  for (int i = 0; i < 4; ++i) { const int ii = 4 * i4 + i; const float kk = kv[ii] * kk4[i] * inv;
                      const float kf = kv[ii] * (1.0f + (af[ii] - 1.0f) * ka4[i]), kb = kv[ii] * (1.0f + (ab[ii] - 1.0f) * ka4[i]);
                      pf[ii] = cvt_pk_bf16(kk * af[ii], kf); pb[ii] = cvt_pk_bf16(kk * ab[ii], kb); vnk[i] = -kk;
                      bon += rr[ii] * (kf + kb) * rk4[i]; }
                  pnk[2 * i4] = cvt_pk_bf16(vnk[0], vnk[1]); pnk[2 * i4 + 1] = cvt_pk_bf16(vnk[2], vnk[3]); }
              if (MODE == 0) { bf16_t* opk = OPS + (m * 8 + h) * OPS_HW + 128 + 32 * g;
#pragma unroll
                  for (int i4 = 0; i4 < 4; ++i4) { *(u32x4*)(opk + 8 * i4) = (u32x4){pf[4 * i4], pf[4 * i4 + 1], pf[4 * i4 + 2], pf[4 * i4 + 3]};
                                                   *(u32x4*)(opk + 256 + 8 * i4) = (u32x4){pb[4 * i4], pb[4 * i4 + 1], pb[4 * i4 + 2], pb[4 * i4 + 3]}; }
                  *(u32x4*)(ops + 512) = (u32x4){pnk[0], pnk[1], pnk[2], pnk[3]}; *(u32x4*)(ops + 520) = (u32x4){pnk[4], pnk[5], pnk[6], pnk[7]}; }
              else asm volatile("" :: "v"(pf[0]), "v"(pb[0]), "v"(pnk[0])); }
            { float vv[16]; PREP_SH16(vv, 1024 + cb);
              if (MODE == 0) { PREP_ST16(ops + 640, vv); PREP_ST16(VSH + m * 512 + cb, vv); } else asm volatile("" :: "v"(vv[0]));
              const bf16x8 bg0 = *(const LAS bf16x8*)(ACTG + tok * 96 + 8 * g), bg1 = *(const LAS bf16x8*)(ACTG + tok * 96 + 32 + 8 * g), bg2 = *(const LAS bf16x8*)(ACTG + tok * 96 + 64 + 8 * g);
              float gg[16];
#pragma unroll
              for (int ct = 0; ct < 4; ++ct) { const bf16_t* gr = GUP + (size_t)(wrow + 4 * ct) * 96 + 8 * g;
                  f32x4 a = __builtin_amdgcn_mfma_f32_16x16x32_bf16(*(const bf16x8*)(gr), bg0, z4, 0, 0, 0);
                  a = __builtin_amdgcn_mfma_f32_16x16x32_bf16(*(const bf16x8*)(gr + 32), bg1, a, 0, 0, 0);
                  a = __builtin_amdgcn_mfma_f32_16x16x32_bf16(*(const bf16x8*)(gr + 64), bg2, a, 0, 0, 0);
#pragma unroll
                  for (int i = 0; i < 4; ++i) gg[4 * ct + i] = a[i]; }
              if (MODE == 0) PREP_ST16(Gb + m * 512 + cb, gg); else asm volatile("" :: "v"(gg[0])); }
            bon = rows4_sum(bon);
            if (g == 0) BON[m * 8 + h] = bon;
#undef PREP_SH16
#undef PREP_ST16
#undef PREP_LD16
        }
    }
    __syncthreads();
}
constexpr int SC_CH = 32;
constexpr int SC_STEP_F = 384;
constexpr int SC_BUF_B = SC_CH * SC_STEP_F * 4;
constexpr int SC_Y_OFF = 2 * SC_BUF_B;

__device__ __forceinline__ int scan_row(int b, int sg, int dir) {
    const int t = dir ? (sg < LC ? (LC - 1 - sg) : (LC + LL - 1 - (sg - LC))) : sg;
    return b * LT + t;
}

template <int MODE>
__device__ __forceinline__ void scan_phase(const Params& p, LAS unsigned char* lds, int bid, int G) {
    const int tid = tid_(), lane = tid & 63, wv = __builtin_amdgcn_readfirstlane(tid >> 6);
    const bf16_t* OPS = (const bf16_t*)(p.ws + WS_OPS);
    constexpr int NCH = LT / SC_CH;
    for (int unit = bid; unit < NB * 8 * 2; unit += G) {
        const int dir = unit & 1, h = (unit >> 1) & 7, b = unit >> 4;
        bf16_t* Yo = (bf16_t*)(p.ws + (dir ? WS_YB : WS_YF));
        __syncthreads();
        const int lt = tid - 256;
#define SC_LOAD_CHUNK(c_) do {   \
            LAS float* buf_ = (LAS float*)(lds + ((c_) & 1) * SC_BUF_B); \
            _Pragma("unroll") for (int j = 0; j < 7; ++j) { const int idx = lt + 256 * j, s = idx / 56, pc = idx % 56; \
                const int m = scan_row(b, (c_) * SC_CH + s, dir); \
                const int src = pc < 16 ? dir * 256 + pc * 8 : (pc < 32 ? dir * 256 + 128 + (pc - 16) * 8 : 256 + pc * 8); \
                const bf16x8 raw = *(const bf16x8*)(OPS + ((size_t)m * 8 + h) * OPS_HW + src); \
                LAS float* d = buf_ + s * SC_STEP_F + (pc < 16 ? pc * 4 : 64 + (pc - 16) * 8); \
                if (pc < 16) { *(LAS bf16x8*)d = raw; } else { float f[8]; unpack8(raw, f); \
                    ((LAS f32x4*)d)[0] = (f32x4){f[0], f[1], f[2], f[3]}; ((LAS f32x4*)d)[1] = (f32x4){f[4], f[5], f[6], f[7]}; } } } while (0)
#define SC_FLUSH_Y(c_) do {   \
            const LAS float* yb_ = (const LAS float*)(lds + SC_Y_OFF + ((c_) & 1) * (SC_CH * 64 * 4)); \
            _Pragma("unroll") for (int j = 0; j < 2; ++j) { const int idx = lt + 256 * j, s = idx >> 4, c4 = (idx & 15) * 4; const int m = scan_row(b, (c_) * SC_CH + s, dir); \
                store_bf4(Yo + (size_t)m * 512 + h * 64 + c4, *(const LAS f32x4*)(yb_ + s * 64 + c4)); } } while (0)
        if (wv >= 4 && MODE != 2) SC_LOAD_CHUNK(0);
        f32x2 Sa[4], Sb[4];
#pragma unroll
        for (int i = 0; i < 4; ++i) { Sa[i] = (f32x2){0.f, 0.f}; Sb[i] = (f32x2){0.f, 0.f}; }
        const int q = lane & 7, il = lane >> 3, row = wv * 16 + 2 * il;
        for (int c = 0; c < NCH; ++c) {
            __syncthreads();
            if (wv >= 4) {
                if (c + 1 < NCH && MODE != 2) SC_LOAD_CHUNK(c + 1);
                if (c >= 1 && MODE == 0) SC_FLUSH_Y(c - 1);
            } else if (MODE != 1) {
                const LAS float* buf = (const LAS float*)(lds + (c & 1) * SC_BUF_B) + 8 * q;
                LAS float* yb = (LAS float*)(lds + SC_Y_OFF + (c & 1) * (SC_CH * 64 * 4));
#define SC_LD(X, s_) const LAS float* sp##X = buf + (s_) * SC_STEP_F; \
                    const f32x4 w0##X = *(const LAS f32x4*)(sp##X), w1##X = *(const LAS f32x4*)(sp##X + 4), b0##X = *(const LAS f32x4*)(sp##X + 64), b1##X = *(const LAS f32x4*)(sp##X + 68), \
                                k0##X = *(const LAS f32x4*)(sp##X + 128), k1##X = *(const LAS f32x4*)(sp##X + 132), n0##X = *(const LAS f32x4*)(sp##X + 192), n1##X = *(const LAS f32x4*)(sp##X + 196), \
                                r0##X = *(const LAS f32x4*)(sp##X + 256), r1##X = *(const LAS f32x4*)(sp##X + 260); \
                    const f32x2 vv##X = *(const LAS f32x2*)(sp##X - 8 * q + 320 + row);
#define LO2(v) __builtin_shufflevector(v, v, 0, 1)
#define HI2(v) __builtin_shufflevector(v, v, 2, 3)
#define SC_STEP(X, s_) { \
                    const f32x2 vA = {vv##X[0], vv##X[0]}, vB = {vv##X[1], vv##X[1]}; \
                      \
                    const f32x2 da = (Sa[0] * LO2(n0##X) + Sa[1] * HI2(n0##X)) + (Sa[2] * LO2(n1##X) + Sa[3] * HI2(n1##X)); \
                    const f32x2 db = (Sb[0] * LO2(n0##X) + Sb[1] * HI2(n0##X)) + (Sb[2] * LO2(n1##X) + Sb[3] * HI2(n1##X)); \
                    f32x2 sa = {da[0] + da[1], db[0] + db[1]}; \
                      \
                    const f32x2 pa0 = Sa[0] * LO2(w0##X) + vA * LO2(k0##X), pa1 = Sa[1] * HI2(w0##X) + vA * HI2(k0##X), pa2 = Sa[2] * LO2(w1##X) + vA * LO2(k1##X), pa3 = Sa[3] * HI2(w1##X) + vA * HI2(k1##X); \
                    const f32x2 pb0 = Sb[0] * LO2(w0##X) + vB * LO2(k0##X), pb1 = Sb[1] * HI2(w0##X) + vB * HI2(k0##X), pb2 = Sb[2] * LO2(w1##X) + vB * LO2(k1##X), pb3 = Sb[3] * HI2(w1##X) + vB * HI2(k1##X); \
                    sa = red8x2(sa); \
                    const f32x2 saA = {sa[0], sa[0]}, saB = {sa[1], sa[1]}; \
                    Sa[0] = pa0 + saA * LO2(b0##X); Sa[1] = pa1 + saA * HI2(b0##X); Sa[2] = pa2 + saA * LO2(b1##X); Sa[3] = pa3 + saA * HI2(b1##X); \
                    Sb[0] = pb0 + saB * LO2(b0##X); Sb[1] = pb1 + saB * HI2(b0##X); Sb[2] = pb2 + saB * LO2(b1##X); Sb[3] = pb3 + saB * HI2(b1##X); \
                    const f32x2 ya = (Sa[0] * LO2(r0##X) + Sa[1] * HI2(r0##X)) + (Sa[2] * LO2(r1##X) + Sa[3] * HI2(r1##X)); \
                    const f32x2 yb2 = (Sb[0] * LO2(r0##X) + Sb[1] * HI2(r0##X)) + (Sb[2] * LO2(r1##X) + Sb[3] * HI2(r1##X)); \
                    f32x2 yy = {ya[0] + ya[1], yb2[0] + yb2[1]}; yy = red8x2(yy); \
                    if (q == 0) *(LAS f32x2*)(yb + (s_) * 64 + row) = yy; }
#pragma unroll 1
                for (int s = 0; s < SC_CH; s += 4) {
                    SC_LD(A, s) SC_LD(B, s + 1)
                    SC_STEP(A, s)
                    SC_LD(C, s + 2)
                    SC_STEP(B, s + 1)
                    SC_LD(D, s + 3)
                    SC_STEP(C, s + 2)
                    SC_STEP(D, s + 3)
                }
#undef LO2
#undef HI2
#undef SC_LD
#undef SC_STEP
            }
        }
        __syncthreads();
        if (wv >= 4 && MODE == 0) SC_FLUSH_Y(NCH - 1);
    }
    __syncthreads();
#undef SC_LOAD_CHUNK
#undef SC_FLUSH_Y
}
constexpr int RT_PQ = 72, RT_PT = 136;
constexpr int RT_QS = 0, RT_KS = RT_QS + 128 * RT_PQ * 2, RT_KDT = RT_KS + 128 * RT_PQ * 2, RT_VT = RT_KDT + 64 * RT_PT * 2,
              RT_PS = RT_VT + 64 * RT_PT * 2, RT_RT = RT_PS + 128 * RT_PT * 2, RT_END = RT_RT + 64 * RT_PQ * 2;
static_assert(RT_END <= 131072, "retention LDS");
__device__ __forceinline__ int crow32(int r, int hi) { return (r & 3) + 8 * (r >> 2) + 4 * hi; }

__device__ __forceinline__ void ret_phase(const Params& p, LAS unsigned char* lds, int bid, int G) {
    const int tid = tid_(), lane = tid & 63, wv = __builtin_amdgcn_readfirstlane(tid >> 6), l31 = lane & 31, hi = lane >> 5;
    LAS bf16_t* Qs = (LAS bf16_t*)(lds + RT_QS); LAS bf16_t* Ks = (LAS bf16_t*)(lds + RT_KS); LAS bf16_t* KdT = (LAS bf16_t*)(lds + RT_KDT);
    LAS bf16_t* VT = (LAS bf16_t*)(lds + RT_VT); LAS bf16_t* Ps = (LAS bf16_t*)(lds + RT_PS); LAS bf16_t* RTt = (LAS bf16_t*)(lds + RT_RT);
    const bf16_t* P = (const bf16_t*)(p.ws + WS_P); const bf16_t* RQ = (const bf16_t*)(p.ws + WS_RQ); const bf16_t* RK = (const bf16_t*)(p.ws + WS_RK);
    for (int unit = bid; unit < NB * 4 * 2 * 2; unit += G) {
        const int vh = unit & 1, dir = (unit >> 1) & 1, h = (unit >> 2) & 3, b = unit >> 4;
        bf16_t* Oo = (bf16_t*)(p.ws + (dir ? WS_OB : WS_OF));
        const float lg2 = log2f(1.0f - exp2f(-5.0f - (float)h - 0.5f * (float)dir));
        const float cdec = exp2f(lg2 * 128.0f);
        f32x16 Racc;
#pragma unroll
        for (int r = 0; r < 16; ++r) Racc[r] = 0.f;
        __syncthreads();
        for (int i = tid; i < 64 * RT_PQ / 2; i += NTHR) ((LAS unsigned*)RTt)[i] = 0u;
        for (int ci = 0; ci < 18; ++ci) {
            const int tc0 = dir ? (ci < 2 ? (1 - ci) * 128 : LC + (17 - ci) * 128) : ci * 128;
            const size_t mc0 = (size_t)b * LT + tc0;
            __syncthreads();
#pragma unroll 1
            for (int j = 0; j < 2; ++j) { const int item = tid + NTHR * j, tok = item >> 3, c8 = item & 7; const size_t m = mc0 + tok;
                const bf16x8 qv = *(const bf16x8*)(RQ + m * 256 + h * 64 + c8 * 8), kv = *(const bf16x8*)(RK + m * 256 + h * 64 + c8 * 8);
                const bf16x8 vv = *(const bf16x8*)(P + m * NPC + PC_RV + h * 128 + vh * 64 + c8 * 8);
                *(LAS bf16x8*)(Qs + tok * RT_PQ + c8 * 8) = qv; *(LAS bf16x8*)(Ks + tok * RT_PQ + c8 * 8) = kv;
                const float kd = exp2f(lg2 * (float)(dir ? tok : 127 - tok));
#pragma unroll
                for (int i = 0; i < 8; ++i) { KdT[(c8 * 8 + i) * RT_PT + tok] = f2bf(bf2f((bf16_t)kv[i]) * kd); VT[(c8 * 8 + i) * RT_PT + tok] = (bf16_t)vv[i]; } }
            __syncthreads();
#pragma unroll 1
            for (int tt = 0; tt < 2; ++tt) { const int tile = wv * 2 + tt, qt = tile >> 2, kt = tile & 3;
                const bool live = dir ? (kt >= qt) : (kt <= qt);
                f32x16 s;
#pragma unroll
                for (int r = 0; r < 16; ++r) s[r] = 0.f;
                if (live) {
#pragma unroll
                    for (int ks = 0; ks < 4; ++ks) { const bf16x8 a = *(const LAS bf16x8*)(Qs + (qt * 32 + l31) * RT_PQ + ks * 16 + hi * 8), bb = *(const LAS bf16x8*)(Ks + (kt * 32 + l31) * RT_PQ + ks * 16 + hi * 8);
                        s = __builtin_amdgcn_mfma_f32_32x32x16_bf16(a, bb, s, 0, 0, 0); }
                }
                const int key = kt * 32 + l31;
#pragma unroll
                for (int r = 0; r < 16; ++r) { const int qq = qt * 32 + crow32(r, hi); const int d = dir ? (key - qq) : (qq - key);
                    const float v = (live && d >= 0) ? s[r] * exp2f(lg2 * (float)d) : 0.f;
                    Ps[qq * RT_PT + key] = f2bf(v); }
            }
            __syncthreads();
            { const int qt = wv >> 1, vt = wv & 1; f32x16 o;
#pragma unroll
                for (int r = 0; r < 16; ++r) o[r] = 0.f;
#pragma unroll
                for (int ks = 0; ks < 4; ++ks) { const bf16x8 a = *(const LAS bf16x8*)(Qs + (qt * 32 + l31) * RT_PQ + ks * 16 + hi * 8), bb = *(const LAS bf16x8*)(RTt + (vt * 32 + l31) * RT_PQ + ks * 16 + hi * 8);
                    o = __builtin_amdgcn_mfma_f32_32x32x16_bf16(a, bb, o, 0, 0, 0); }
#pragma unroll
                for (int r = 0; r < 16; ++r) { const int pos = qt * 32 + crow32(r, hi); o[r] *= exp2f(lg2 * (float)(dir ? 128 - pos : pos + 1)); }
#pragma unroll
                for (int ks = 0; ks < 8; ++ks) { const bf16x8 a = *(const LAS bf16x8*)(Ps + (qt * 32 + l31) * RT_PT + ks * 16 + hi * 8), bb = *(const LAS bf16x8*)(VT + (vt * 32 + l31) * RT_PT + ks * 16 + hi * 8);
                    o = __builtin_amdgcn_mfma_f32_32x32x16_bf16(a, bb, o, 0, 0, 0); }
#pragma unroll
                for (int r = 0; r < 16; ++r) Oo[(mc0 + qt * 32 + crow32(r, hi)) * 512 + h * 128 + vh * 64 + vt * 32 + l31] = f2bf(o[r]);
            }
            if (wv < 4) { const int dkt = wv >> 1, vt = wv & 1;
#pragma unroll
                for (int r = 0; r < 16; ++r) Racc[r] *= cdec;
#pragma unroll
                for (int ks = 0; ks < 8; ++ks) { const bf16x8 a = *(const LAS bf16x8*)(KdT + (dkt * 32 + l31) * RT_PT + ks * 16 + hi * 8), bb = *(const LAS bf16x8*)(VT + (vt * 32 + l31) * RT_PT + ks * 16 + hi * 8);
                    Racc = __builtin_amdgcn_mfma_f32_32x32x16_bf16(a, bb, Racc, 0, 0, 0); }
            }
            __syncthreads();
            if (wv < 4) { const int dkt = wv >> 1, vt = wv & 1;
#pragma unroll
                for (int r = 0; r < 16; ++r) RTt[(vt * 32 + l31) * RT_PQ + dkt * 32 + crow32(r, hi)] = f2bf(Racc[r]); }
        }
    }
    __syncthreads();
}
namespace att {
constexpr int QBLK = 32, KVBLK = 64;
constexpr float SCALE = 0.07216878364870322f;
constexpr float THR = 8.f;
constexpr int SHM_T = KVBLK * 128 * 2;
constexpr int OFF_V = 0, OFF_KN = 2 * SHM_T, OFF_KR = 4 * SHM_T, OFF_WS = 6 * SHM_T;
#define KSWZ(row, colB) ((row) * 256 + ((colB) ^ (((row) & 7) << 4)))
#define SBAR() __builtin_amdgcn_sched_barrier(0)
__device__ __forceinline__ int crow(int r, int hi) { return (r & 3) + 8 * (r >> 2) + 4 * hi; }

__device__ __forceinline__ void partialSM(f32x16& p0, f32x16& p1, float& m_reg, float& mn, float& alpha) {
  constexpr float C = SCALE * 1.4426950408889634f;
  float pmax = p0[0];
#pragma unroll
  for (int r = 1; r < 16; ++r) pmax = fmaxf(pmax, p0[r]);
#pragma unroll
  for (int r = 0; r < 16; ++r) pmax = fmaxf(pmax, p1[r]);
  { auto rr = __builtin_amdgcn_permlane32_swap(__float_as_uint(pmax), __float_as_uint(pmax), false, false);
    pmax = fmaxf(__uint_as_float(rr[0]), __uint_as_float(rr[1])); }
  if (__builtin_expect(__all(pmax - m_reg <= THR / SCALE), 1)) { mn = m_reg; alpha = 1.f; }
  else { mn = fmaxf(m_reg, pmax); alpha = __builtin_amdgcn_exp2f((m_reg - mn) * C); m_reg = mn; }
  const float mnC = -mn * C;
#pragma unroll
  for (int r = 0; r < 16; ++r) p0[r] = __builtin_amdgcn_exp2f(fmaf(p0[r], C, mnC));
#pragma unroll
  for (int r = 0; r < 16; ++r) p1[r] = __builtin_amdgcn_exp2f(fmaf(p1[r], C, mnC));
}
__device__ __forceinline__ void finishSM(const f32x16& p0, const f32x16& p1, float alpha, float& l_reg, bf16x8& pa0, bf16x8& pa1, bf16x8& pa2, bf16x8& pa3) {
  float ps = 0;
#pragma unroll
  for (int r = 0; r < 16; ++r) ps += p0[r];
#pragma unroll
  for (int r = 0; r < 16; ++r) ps += p1[r];
  { auto rr = __builtin_amdgcn_permlane32_swap(__float_as_uint(ps), __float_as_uint(ps), false, false);
    ps = __uint_as_float(rr[0]) + __uint_as_float(rr[1]); }
  l_reg = l_reg * alpha + ps;
#define PK4(P, BASE, OUT) do { unsigned a0 = cvt_pk_bf16(P[BASE + 0], P[BASE + 1]), a1 = cvt_pk_bf16(P[BASE + 2], P[BASE + 3]);   \
    unsigned b0 = cvt_pk_bf16(P[BASE + 4], P[BASE + 5]), b1 = cvt_pk_bf16(P[BASE + 6], P[BASE + 7]);                              \
    auto r0 = __builtin_amdgcn_permlane32_swap(a0, b0, false, false); auto r1 = __builtin_amdgcn_permlane32_swap(a1, b1, false, false); \
    u32x4 w = {r0[0], r1[0], r0[1], r1[1]}; OUT = *reinterpret_cast<bf16x8*>(&w); } while (0)
  PK4(p0, 0, pa0); PK4(p0, 8, pa1); PK4(p1, 0, pa2); PK4(p1, 8, pa3);
#undef PK4
}
__device__ __forceinline__ int v_st(int k, int c) { const int kk = (k & ~0xC) | ((k & 4) << 1) | ((k & 8) >> 1); return ((kk >> 3) * 4 + (c >> 5)) * 512 + ((kk & 7) * 32 + (c & 31)) * 2; }
__device__ __forceinline__ int v_rd_base(int lane) { return ((lane & 3) << 3) | (((lane >> 2) & 3) << 6) | (((lane >> 4) & 1) << 5) | (((lane >> 5) & 1) << 8); }
constexpr int v_rd_off(int d0, int ks, int half) { return d0 * 512 + ks * 4096 + half * 2048; }
template <int OFF> __device__ __forceinline__ s16x4 tr_read(int vb) {
  s16x4 r; asm volatile("ds_read_b64_tr_b16 %0, %1 offset:%2" : "=&v"(r) : "v"(vb), "i"(OFF) : "memory"); return r;
}
template <int D0> __device__ __forceinline__ void pv_one(f32x16& od, int vb, bf16x8 pa0, bf16x8 pa1, bf16x8 pa2, bf16x8 pa3) {
  const s16x4 l0 = tr_read<v_rd_off(D0, 0, 0)>(vb), h0 = tr_read<v_rd_off(D0, 0, 1)>(vb), l1 = tr_read<v_rd_off(D0, 1, 0)>(vb), h1 = tr_read<v_rd_off(D0, 1, 1)>(vb);
  const s16x4 l2 = tr_read<v_rd_off(D0, 2, 0)>(vb), h2 = tr_read<v_rd_off(D0, 2, 1)>(vb), l3 = tr_read<v_rd_off(D0, 3, 0)>(vb), h3 = tr_read<v_rd_off(D0, 3, 1)>(vb);
  asm volatile("s_waitcnt lgkmcnt(0)" ::: "memory"); SBAR();
#define PKV(L, H) (bf16x8){L[0], L[1], L[2], L[3], H[0], H[1], H[2], H[3]}
  od = __builtin_amdgcn_mfma_f32_32x32x16_bf16(pa0, PKV(l0, h0), od, 0, 0, 0);
  od = __builtin_amdgcn_mfma_f32_32x32x16_bf16(pa1, PKV(l1, h1), od, 0, 0, 0);
  od = __builtin_amdgcn_mfma_f32_32x32x16_bf16(pa2, PKV(l2, h2), od, 0, 0, 0);
  od = __builtin_amdgcn_mfma_f32_32x32x16_bf16(pa3, PKV(l3, h3), od, 0, 0, 0);
#undef PKV
}

__device__ __forceinline__ void attn_unit(const bf16_t* __restrict__ Qb, int rope_pos0, const bf16_t* __restrict__ Kn, const bf16_t* __restrict__ Vp, const bf16_t* __restrict__ Kr,
                                          bf16_t* __restrict__ Ob, int nkeys, const float* __restrict__ COS, const float* __restrict__ SIN, LAS unsigned char* ldsb) {
  LAS char* lds = (LAS char*)ldsb;
  const int tid = tid_(), wid = tid >> 6, lane = tid & 63, r32 = lane & 31, hi = lane >> 5;
  LAS float* ws = (LAS float*)(lds + OFF_WS) + wid * 64; LAS float* li_l = ws; LAS float* al_l = ws + 32;
  float m_reg = -1e30f, l_reg = 0; f32x16 o[4]; bf16x8 qr[12];
#pragma unroll
  for (int d = 0; d < 4; ++d)
#pragma unroll
    for (int r = 0; r < 16; ++r) o[d][r] = 0.f;
  const bf16_t* Qw = Qb + (size_t)(wid * QBLK + r32) * 1536 + hi * 8;
#pragma unroll
  for (int d0 = 0; d0 < 8; ++d0) qr[d0] = *(const bf16x8*)(Qw + d0 * 16);
#pragma unroll
  for (int d0 = 8; d0 < 12; ++d0) {
    bf16x8 x = *(const bf16x8*)(Qw + 128 + (d0 - 8) * 16);
    if (rope_pos0 >= 0) { const int pos = rope_pos0 + wid * QBLK + r32, pi = (d0 - 8) * 8 + hi * 4;
      const f32x4 c = *(const f32x4*)(COS + pos * 32 + pi), s = *(const f32x4*)(SIN + pos * 32 + pi);
      float f[8]; unpack8(x, f); float g[8];
#pragma unroll
      for (int i = 0; i < 4; ++i) { g[2 * i] = f[2 * i] * c[i] - f[2 * i + 1] * s[i]; g[2 * i + 1] = f[2 * i] * s[i] + f[2 * i + 1] * c[i]; }
      x = pack8(g); }
    qr[d0] = x; }
  const int sr = tid >> 4, sc = (tid & 15) * 8, vst0 = v_st(sr, sc), vst1 = v_st(32 + sr, sc);
  const int kr_r = tid >> 3, kr_c = (tid & 7) * 8;
  const int vb0 = (int)(uintptr_t)(lds + OFF_V) + v_rd_base(lane);
  bf16x8 vs0, vs1, ks0, ks1, krs;
#define SLOAD(k0) do { vs0 = *(const bf16x8*)(Vp + (size_t)((k0) + sr) * 2048 + sc); vs1 = *(const bf16x8*)(Vp + (size_t)((k0) + 32 + sr) * 2048 + sc); \
    ks0 = *(const bf16x8*)(Kn + (size_t)((k0) + sr) * 2048 + sc); ks1 = *(const bf16x8*)(Kn + (size_t)((k0) + 32 + sr) * 2048 + sc); \
    krs = *(const bf16x8*)(Kr + (size_t)((k0) + kr_r) * 64 + kr_c); } while (0)
#define SWRITE(b) do { *(LAS bf16x8*)(lds + OFF_V + (b) * SHM_T + vst0) = vs0; *(LAS bf16x8*)(lds + OFF_V + (b) * SHM_T + vst1) = vs1; \
    *(LAS bf16x8*)(lds + OFF_KN + (b) * SHM_T + KSWZ(sr, sc * 2)) = ks0; *(LAS bf16x8*)(lds + OFF_KN + (b) * SHM_T + KSWZ(32 + sr, sc * 2)) = ks1; \
    *(LAS bf16x8*)(lds + OFF_KR + (b) * SHM_T + KSWZ(kr_r, kr_c * 2)) = krs; } while (0)
  const int NT = nkeys / KVBLK;
  __syncthreads();
  SLOAD(0); SWRITE(0); __syncthreads();
  for (int j = 0; j < NT; ++j) {
    const int bsel = j & 1;
    f32x16 p0, p1;
#pragma unroll
    for (int r = 0; r < 16; ++r) { p0[r] = 0.f; p1[r] = 0.f; }
    { const LAS char* Kn_l = lds + OFF_KN + bsel * SHM_T; const LAS char* Kr_l = lds + OFF_KR + bsel * SHM_T;
#pragma unroll
      for (int d0 = 0; d0 < 8; ++d0) { const int cb = (d0 * 16 + hi * 8) * 2;
        const bf16x8 b0 = *(const LAS bf16x8*)(Kn_l + KSWZ(r32, cb)), b1 = *(const LAS bf16x8*)(Kn_l + KSWZ(32 + r32, cb));
        p0 = __builtin_amdgcn_mfma_f32_32x32x16_bf16(b0, qr[d0], p0, 0, 0, 0); p1 = __builtin_amdgcn_mfma_f32_32x32x16_bf16(b1, qr[d0], p1, 0, 0, 0); }
#pragma unroll
      for (int d0 = 8; d0 < 12; ++d0) { const int cb = ((d0 - 8) * 16 + hi * 8) * 2;
        const bf16x8 b0 = *(const LAS bf16x8*)(Kr_l + KSWZ(r32, cb)), b1 = *(const LAS bf16x8*)(Kr_l + KSWZ(32 + r32, cb));
        p0 = __builtin_amdgcn_mfma_f32_32x32x16_bf16(b0, qr[d0], p0, 0, 0, 0); p1 = __builtin_amdgcn_mfma_f32_32x32x16_bf16(b1, qr[d0], p1, 0, 0, 0); }
    }
    float mn, alpha; partialSM(p0, p1, m_reg, mn, alpha);
    if (j + 1 < NT) SLOAD((j + 1) * KVBLK);
    if (__any(alpha < 1.f)) { if (hi == 0) al_l[r32] = alpha; asm volatile("s_waitcnt lgkmcnt(0)" ::: "memory");
#pragma unroll
      for (int d = 0; d < 4; ++d)
#pragma unroll
        for (int r = 0; r < 16; ++r) o[d][r] *= al_l[crow(r, hi)]; }
    bf16x8 pa0, pa1, pa2, pa3; finishSM(p0, p1, alpha, l_reg, pa0, pa1, pa2, pa3); SBAR();
    { const int vb = vb0 + bsel * SHM_T;
      pv_one<0>(o[0], vb, pa0, pa1, pa2, pa3); pv_one<1>(o[1], vb, pa0, pa1, pa2, pa3); pv_one<2>(o[2], vb, pa0, pa1, pa2, pa3); pv_one<3>(o[3], vb, pa0, pa1, pa2, pa3); }
    if (j + 1 < NT) SWRITE(bsel ^ 1);
    __syncthreads();
  }
  if (hi == 0) li_l[r32] = l_reg; asm volatile("s_waitcnt lgkmcnt(0)" ::: "memory");
  float rli[16];
#pragma unroll
  for (int r = 0; r < 16; ++r) rli[r] = __builtin_amdgcn_rcpf(li_l[crow(r, hi)]);
  bf16_t* Ow = Ob + (size_t)(wid * QBLK) * 2048;
#pragma unroll
  for (int r = 0; r < 16; ++r) { const int orow = crow(r, hi);
#pragma unroll
    for (int d0 = 0; d0 < 4; ++d0) Ow[(size_t)orow * 2048 + d0 * 32 + r32] = f2bf(o[d0][r] * rli[r]); }
#undef SLOAD
#undef SWRITE
}
#undef KSWZ
#undef SBAR
}

__device__ __forceinline__ void attn_phase(const Params& p, LAS unsigned char* lds, int l, int bid, int G) {
    const bf16_t* Q = (const bf16_t*)(p.ws + WS_Q); const bf16_t* KV = (const bf16_t*)(p.ws + WS_KV); const bf16_t* KR = (const bf16_t*)(p.ws + WS_KR);
    bf16_t* MIX = (bf16_t*)(p.ws + WS_MIX);
    const float* COS = (const float*)(p.ws + WS_COS); const float* SIN = (const float*)(p.ws + WS_SIN);
    const int nlat = NB * 8 * 8, nctx = (l < DEPTH - 1) ? NB * 8 : 0;
    const int x = bid & 7, jj = bid >> 3;
    const bool young = __builtin_amdgcn_readfirstlane(tid_()) >= 256;
    if (young) __builtin_amdgcn_s_setprio(1);
    for (int rnd = 0; ; ++rnd) {
        int u;
        if (G == 256) { const int pair = rnd * 32 + x * 4 + (jj >> 3); u = pair * 8 + (jj & 7); if (pair >= NB * 8) u = nlat + (rnd - 4) * 256 + bid; }
        else u = rnd * G + bid;
        if (u >= nlat + nctx) break;
        int b, h, qrow, rpos, nk;
        if (u < nlat) { const int qb = u & 7; h = (u >> 3) & 7; b = u >> 6; qrow = LC + qb * 256; rpos = qb * 256; nk = LT; }
        else { const int v = u - nlat; h = v & 7; b = v >> 3; qrow = 0; rpos = -1; nk = LC; }
        const size_t k0 = (size_t)b * LT, r0 = k0 + qrow;
        att::attn_unit(Q + r0 * 1536 + h * 192, rpos, KV + k0 * 2048 + h * 256, KV + k0 * 2048 + h * 256 + 128, KR + k0 * 64, MIX + r0 * 2048 + 512 + h * 128, nk, COS, SIN, lds);
    }
    __builtin_amdgcn_s_setprio(0);
    __syncthreads();
}
__device__ __forceinline__ void finish_phase(const Params& p, int l, int bid, int G) {
    const int tid = tid_(), lane = tid & 63, wv = tid >> 6;
    const bf16_t* YF = (const bf16_t*)(p.ws + WS_YF); const bf16_t* YB = (const bf16_t*)(p.ws + WS_YB);
    const bf16_t* OF = (const bf16_t*)(p.ws + WS_OF); const bf16_t* OB = (const bf16_t*)(p.ws + WS_OB);
    const bf16_t* VSH = (const bf16_t*)(p.ws + WS_VSH); const bf16_t* Gb = (const bf16_t*)(p.ws + WS_G); const float* BON = (const float*)(p.ws + WS_BON);
    const bf16_t* P = (const bf16_t*)(p.ws + WS_P);
    bf16_t* MIX = (bf16_t*)(p.ws + WS_MIX);
    const float* gng = p.in[I_GNG] + l * 512; const float* gnb = p.in[I_GNB] + l * 512;
    const float* rgg = p.in[I_RGG] + l * 512; const float* rgb = p.in[I_RGB] + l * 512;
    const int c = lane * 8;
    for (int m = bid * 8 + wv; m < MT; m += G * 8) {
        if (l == DEPTH - 1 && (m % LT) < LC) continue;
        {
            const int h = lane >> 3;
            float y[8]; { float ya[8], yb8[8]; unpack8(*(const bf16x8*)(YF + (size_t)m * 512 + c), ya); unpack8(*(const bf16x8*)(YB + (size_t)m * 512 + c), yb8);
#pragma unroll
                          for (int i = 0; i < 8; ++i) y[i] = ya[i] + yb8[i]; }
            float s = 0.f;
#pragma unroll
            for (int i = 0; i < 8; ++i) s += y[i];
            const float mean = red8(s) * (1.0f / 64.0f); float q = 0.f;
#pragma unroll
            for (int i = 0; i < 8; ++i) { y[i] -= mean; q += y[i] * y[i]; }
            const float rstd = rsqrtf(red8(q) * (1.0f / 64.0f) + 64e-5f);
            float vv[8], gg[8]; unpack8(*(const bf16x8*)(VSH + (size_t)m * 512 + c), vv); unpack8(*(const bf16x8*)(Gb + (size_t)m * 512 + c), gg);
            const float bon = BON[(size_t)m * 8 + h];
            float o[8];
#pragma unroll
            for (int i = 0; i < 8; ++i) o[i] = (y[i] * rstd * gng[c + i] + gnb[c + i] + bon * vv[i]) * gg[i];
            *(bf16x8*)(MIX + (size_t)m * DM + c) = pack8(o);
        }
        {
            float y[8]; { float ya[8], yb8[8]; unpack8(*(const bf16x8*)(OF + (size_t)m * 512 + c), ya); unpack8(*(const bf16x8*)(OB + (size_t)m * 512 + c), yb8);
#pragma unroll
                          for (int i = 0; i < 8; ++i) y[i] = ya[i] + yb8[i]; }
            float s = 0.f;
#pragma unroll
            for (int i = 0; i < 8; ++i) s += y[i];
            const float mean = row16_sum(s) * (1.0f / 128.0f); float q = 0.f;
#pragma unroll
            for (int i = 0; i < 8; ++i) { y[i] -= mean; q += y[i] * y[i]; }
            const float rstd = rsqrtf(row16_sum(q) * (1.0f / 128.0f) + 1e-5f);
            float gt[8]; unpack8(*(const bf16x8*)(P + (size_t)m * NPC + PC_RG + c), gt);
            float o[8];
#pragma unroll
            for (int i = 0; i < 8; ++i) o[i] = (y[i] * rstd * rgg[c + i] + rgb[c + i]) * siluf_(gt[i]);
            *(bf16x8*)(MIX + (size_t)m * DM + 1536 + c) = pack8(o);
        }
    }
}
namespace co {
constexpr int TS = 8, NTS = LT / TS;
constexpr int A_V = 0, A_KN = 32768, A_KR = 65536, A_WS = 81920;
constexpr int CO_STEP_B = 896;
constexpr int CO_BK = 256, CO_R = 512, CO_N = 640, CO_V = 768;
constexpr int S_SBB = TS * CO_STEP_B, S_SB = 83968, S_YB = TS * 64 * 4, S_Y = S_SB + 2 * S_SBB;
static_assert(S_Y + 3 * S_YB <= 131072, "co-run LDS");
#define CO_BAR() do { asm volatile("s_waitcnt vmcnt(0) lgkmcnt(0)" ::: "memory"); __builtin_amdgcn_s_barrier(); asm volatile("" ::: "memory"); } while (0)
#define CO_BAR_S() do { asm volatile("s_waitcnt lgkmcnt(0)" ::: "memory"); __builtin_amdgcn_s_barrier(); asm volatile("" ::: "memory"); } while (0)

template <int NOLD, int ROLE>
__device__ __forceinline__ void scan_role(const Params& p, LAS unsigned char* ldsb, int unit, int T) {
    LAS char* lds = (LAS char*)ldsb;
    const int tid = tid_() - (ROLE == 2 ? 256 : 0), lane = tid & 63, wv = __builtin_amdgcn_readfirstlane(tid >> 6);
    const int dir = unit & 1, h = (unit >> 1) & 7, b = unit >> 4;
    const bf16_t* OPS = (const bf16_t*)(p.ws + WS_OPS); bf16_t* Yo = (bf16_t*)(p.ws + (dir ? WS_YB : WS_YF));
    const int n = lane & 15, j = lane >> 4;
    const int sA = tid / 56, pA = tid % 56; const int iB = 256 + (tid < 192 ? tid : 0), sB = iB / 56, pB = iB % 56; const bool hasB = tid < 192;
#define CO_SRC(pc_) ((pc_) < 32 ? dir * 256 + (pc_) * 8 : 256 + (pc_) * 8)
#define CO_DST(pc_) ((pc_) < 16 ? (pc_) * 16 : ((pc_) < 32 ? CO_BK + 64 * ((((pc_) - 16) >> 1) & 3) + 4 * (2 * (((pc_) - 16) >> 3) + ((pc_) & 1)) : ((pc_) < 40 ? CO_N + ((pc_) - 32) * 16 : ((pc_) < 48 ? CO_R + ((pc_) - 40) * 16 : CO_V + ((pc_) - 48) * 16))))
    const int srcA = CO_SRC(pA), dstA = CO_DST(pA), srcB = CO_SRC(pB), dstB = CO_DST(pB); const int shA = (pA >= 40 && pA < 48) ? 1 : 0, shB = (pB >= 40 && pB < 48) ? 1 : 0;
    const bool bkA = pA >= 16 && pA < 32, bkB = pB >= 16 && pB < 32;
#define CO_G(k_, s_, sh_) ({ int g_ = (k_) * TS + (s_) - (sh_); g_ = g_ < 0 ? 0 : (g_ > LT - 1 ? LT - 1 : g_); g_; })
#define CO_LDOP(k_, s_, src_, sh_) (*(const bf16x8*)(OPS + ((size_t)scan_row(b, CO_G(k_, s_, sh_), dir) * 8 + h) * OPS_HW + (src_)))
#define CO_WROP(reg_, k_, s_, dst_, isbk_) do { LAS char* d_ = lds + S_SB + ((k_) & 1) * S_SBB + (s_) * CO_STEP_B + (dst_); \
        if (isbk_) { const u32x4 r_ = __builtin_bit_cast(u32x4, reg_); *(LAS unsigned*)d_ = r_[0]; *(LAS unsigned*)(d_ + 16) = r_[1]; *(LAS unsigned*)(d_ + 32) = r_[2]; *(LAS unsigned*)(d_ + 48) = r_[3]; } \
        else *(LAS bf16x8*)d_ = reg_; } while (0)
    bf16x8 ra, rb, rc, rd;
#pragma unroll
    for (int i = 0; i < 8; ++i) { ra[i] = 0; rb[i] = 0; rc[i] = 0; rd[i] = 0; }
    if (ROLE != 1) {
        ra = CO_LDOP(0, sA, srcA, shA); rb = ra; if (hasB) rb = CO_LDOP(0, sB, srcB, shB);
        CO_WROP(ra, 0, sA, dstA, bkA); if (hasB) CO_WROP(rb, 0, sB, dstB, bkB);
        ra = CO_LDOP(1, sA, srcA, shA); if (hasB) rb = CO_LDOP(1, sB, srcB, shB);
        if (ROLE == 2) { rc = CO_LDOP(2, sA, srcA, shA); rd = rc; if (hasB) rd = CO_LDOP(2, sB, srcB, shB); }
    }
    f32x4 T0 = {0.f, 0.f, 0.f, 0.f}, T1 = T0, T2 = T0, T3 = T0; bf16x8 Tb0, Tb1;
#pragma unroll
    for (int i = 0; i < 8; ++i) { Tb0[i] = 0; Tb1[i] = 0; }
    const f32x4 z4 = {0.f, 0.f, 0.f, 0.f};
    const int o_dot = (n == 0 ? CO_R : CO_N) + 16 * j;
    const int o_w = 32 * j;
    const int o_bk = CO_BK + 16 * n;
    const int o_v = CO_V + 2 * (wv * 16 + n);
    LAS float* yr = (LAS float*)(lds + S_Y) + wv * 16 + n;
    CO_BAR_S();
    if (ROLE == 1) __builtin_amdgcn_s_setprio(2);
#define SC_LD(X, s_) const LAS char* sp##X = buf + (s_) * CO_STEP_B; \
        const bf16x8 a0##X = *(const LAS bf16x8*)(sp##X + o_dot), a1##X = *(const LAS bf16x8*)(sp##X + o_dot + 64); \
        const f32x4 w0##X = *(const LAS f32x4*)(sp##X + o_w), w1##X = *(const LAS f32x4*)(sp##X + o_w + 16), w2##X = *(const LAS f32x4*)(sp##X + o_w + 128), w3##X = *(const LAS f32x4*)(sp##X + o_w + 144); \
        const bf16x8 bk##X = *(const LAS bf16x8*)(sp##X + o_bk); \
        const unsigned v16##X = *(const LAS unsigned short*)(sp##X + o_v);
#define SC_DOT(X, yv_)   \
        const f32x4 Da##X = __builtin_amdgcn_mfma_f32_16x16x32_bf16(a0##X, Tb0, z4, 0, 0, 0), Db##X = __builtin_amdgcn_mfma_f32_16x16x32_bf16(a1##X, Tb1, z4, 0, 0, 0); \
        const f32x2 D##X = {Da##X[0] + Db##X[0], Da##X[1] + Db##X[1]}; \
        yv_ = D##X[0];
#define SC_STEP(X, yv_) { SC_DOT(X, yv_) \
        const unsigned pk_ = cvt_pk_bf16(D##X[1], __uint_as_float(v16##X << 16)); \
        const unsigned pz_ = j == 0 ? pk_ : 0u; \
        T0 = __builtin_amdgcn_mfma_f32_16x16x32_bf16(bk##X, __builtin_bit_cast(bf16x8, (u32x4){pz_, 0u, 0u, 0u}), T0 * w0##X, 0, 0, 0); \
        T1 = __builtin_amdgcn_mfma_f32_16x16x32_bf16(bk##X, __builtin_bit_cast(bf16x8, (u32x4){0u, pz_, 0u, 0u}), T1 * w1##X, 0, 0, 0); \
        T2 = __builtin_amdgcn_mfma_f32_16x16x32_bf16(bk##X, __builtin_bit_cast(bf16x8, (u32x4){0u, 0u, pz_, 0u}), T2 * w2##X, 0, 0, 0); \
        T3 = __builtin_amdgcn_mfma_f32_16x16x32_bf16(bk##X, __builtin_bit_cast(bf16x8, (u32x4){0u, 0u, 0u, pz_}), T3 * w3##X, 0, 0, 0); \
        Tb0 = __builtin_bit_cast(bf16x8, (u32x4){cvt_pk_bf16(T0[0], T0[1]), cvt_pk_bf16(T0[2], T0[3]), cvt_pk_bf16(T1[0], T1[1]), cvt_pk_bf16(T1[2], T1[3])}); \
        Tb1 = __builtin_bit_cast(bf16x8, (u32x4){cvt_pk_bf16(T2[0], T2[1]), cvt_pk_bf16(T2[2], T2[3]), cvt_pk_bf16(T3[0], T3[1]), cvt_pk_bf16(T3[2], T3[3])}); }
#define CO_FLUSH(kk_, third_) do { if (tid < 64) { const int st_ = tid >> 3, cc_ = (tid & 7) * 8; const LAS float* ys_ = (const LAS float*)(lds + S_Y + (third_) * S_YB) + st_ * 64 + cc_; \
        const f32x4 y0_ = *(const LAS f32x4*)ys_, y1_ = *(const LAS f32x4*)(ys_ + 4); float f_[8] = {y0_[0], y0_[1], y0_[2], y0_[3], y1_[0], y1_[1], y1_[2], y1_[3]}; \
        if (!NOLD) *(bf16x8*)(Yo + (size_t)scan_row(b, (kk_) * TS + st_, dir) * 512 + h * 64 + cc_) = pack8(f_); else asm volatile("" :: "v"(f_[0])); } } while (0)
    int k3 = 0;
#pragma unroll 1
    for (int k = 0; k < T; ++k) {
        const int kp1 = k3 == 2 ? 0 : k3 + 1, km1 = k3 == 0 ? 2 : k3 - 1;
        if (k <= NTS) {
            if (ROLE != 1) {
                if (k + 1 <= NTS) { CO_WROP(ra, k + 1, sA, dstA, bkA); if (hasB) CO_WROP(rb, k + 1, sB, dstB, bkB); }
                if (ROLE == 0) { if (k + 2 <= NTS && !NOLD) { ra = CO_LDOP(k + 2, sA, srcA, shA); if (hasB) rb = CO_LDOP(k + 2, sB, srcB, shB); } }
                else { ra = rc; rb = rd; if (k + 3 <= NTS && !NOLD) { rc = CO_LDOP(k + 3, sA, srcA, shA); if (hasB) rd = CO_LDOP(k + 3, sB, srcB, shB); } }
                if (k >= 2) CO_FLUSH(k - 2, kp1);
            }
            const LAS char* buf = lds + S_SB + (k & 1) * S_SBB;
            if (ROLE == 2) {} else if (k < NTS) {
                float y0, y1, y2, y3, y4, y5, y6, y7;
                { SC_LD(A, 0) SC_LD(B, 1) SC_STEP(A, y0) SC_LD(C, 2) SC_STEP(B, y1) SC_LD(D, 3) SC_STEP(C, y2) SC_LD(E, 4) SC_STEP(D, y3)
                  SC_LD(F, 5) SC_STEP(E, y4) SC_LD(G, 6) SC_STEP(F, y5) SC_LD(H, 7) SC_STEP(G, y6) SC_STEP(H, y7) }
                if (j == 0) { yr[(km1 * 8 + 7) * 64] = y0; LAS float* y_ = yr + k3 * 512; y_[0] = y1; y_[64] = y2; y_[128] = y3; y_[192] = y4; y_[256] = y5; y_[320] = y6; y_[384] = y7; }
            } else { float y0; { SC_LD(A, 0) SC_DOT(A, y0) } if (j == 0) yr[(km1 * 8 + 7) * 64] = y0; }
        } else if (k == NTS + 1 && ROLE != 1) CO_FLUSH(NTS - 1, kp1);
        k3 = kp1;
        CO_BAR_S();
    }
    if (ROLE == 1) __builtin_amdgcn_s_setprio(0);
#undef CO_LDOP
#undef CO_WROP
#undef CO_SRC
#undef CO_DST
#undef CO_G
#undef CO_FLUSH
#undef SC_LD
#undef SC_DOT
#undef SC_STEP
}

struct AUnit { int b, h, qrow, rope, nk; };
__device__ __forceinline__ AUnit a_unit(int i, int bid) {
    AUnit u;
    if (i < 8) { const int x = bid & 7, jj = bid >> 3, pair = i * 16 + x * 2 + (jj >> 4), qh = jj & 15; u.b = pair >> 3; u.h = pair & 7; u.qrow = LC + qh * 128; u.rope = qh * 128; u.nk = LT; }
    else { const int pair = bid >> 1, half = bid & 1; u.b = pair >> 3; u.h = pair & 7; u.qrow = half * 128; u.rope = -1; u.nk = LC; }
    return u;
}
__device__ __forceinline__ void attn_role(const Params& p, LAS unsigned char* ldsb, int bid, int Tatt, int T) {
    using namespace att;
    LAS char* lds = (LAS char*)ldsb;
    const int tid = tid_() - 256, aw = __builtin_amdgcn_readfirstlane(tid >> 6), lane = tid & 63, r32 = lane & 31, hi = lane >> 5;
    const bf16_t* Q = (const bf16_t*)(p.ws + WS_Q); const bf16_t* KV = (const bf16_t*)(p.ws + WS_KV); const bf16_t* KRb = (const bf16_t*)(p.ws + WS_KR);
    bf16_t* MIX = (bf16_t*)(p.ws + WS_MIX);
    const float* COS = (const float*)(p.ws + WS_COS); const float* SIN = (const float*)(p.ws + WS_SIN);
    LAS float* ws = (LAS float*)(lds + A_WS) + aw * 64; LAS float* li_l = ws; LAS float* al_l = ws + 32;
    int offV[4], offK[4], offR[2];
#pragma unroll
    for (int n = 0; n < 4; ++n) { const int pp = (aw + 4 * n) * 1024 + lane * 16;
        { const int sub = pp >> 9, within = (pp & 511) >> 1, kk = (sub >> 2) * 8 + (within >> 5), c = (sub & 3) * 32 + (within & 31);
          const int k = (kk & ~0xC) | ((kk & 4) << 1) | ((kk & 8) >> 1); offV[n] = k * 2048 + c; }
        { const int rowk = pp >> 8, colB = (pp & 255) ^ ((rowk & 7) << 4); offK[n] = rowk * 2048 + (colB >> 1); } }
#pragma unroll
    for (int n = 0; n < 2; ++n) { const int pp = (aw + 4 * n) * 1024 + lane * 16; const int rowk = pp >> 7, chunk = ((pp & 127) >> 4) ^ ((rowk >> 1) & 7); offR[n] = rowk * 64 + chunk * 8; }
    const int krsw = ((r32 >> 1) & 7);
    const int vb0 = (int)(uintptr_t)(lds + A_V) + v_rd_base(lane);
#define CO_DMA(kk_) do { const int ui_ = (kk_) < 288 ? (kk_) / 36 : 8, j_ = (kk_) < 288 ? (kk_) % 36 : (kk_) - 288; const AUnit u_ = a_unit(ui_, bid); \
        const size_t kr0_ = (size_t)u_.b * LT + (size_t)j_ * 64; const bf16_t* kn_ = KV + kr0_ * 2048 + u_.h * 256; const bf16_t* kr_ = KRb + kr0_ * 64; const int bs_ = ((kk_) & 1); \
        _Pragma("unroll") for (int n = 0; n < 4; ++n) { \
            __builtin_amdgcn_global_load_lds((const unsigned*)(kn_ + 128 + offV[n]), (LAS unsigned*)(lds + A_V + bs_ * 16384 + (aw + 4 * n) * 1024), 16, 0, 0); \
            __builtin_amdgcn_global_load_lds((const unsigned*)(kn_ + offK[n]), (LAS unsigned*)(lds + A_KN + bs_ * 16384 + (aw + 4 * n) * 1024), 16, 0, 0); } \
        _Pragma("unroll") for (int n = 0; n < 2; ++n) \
            __builtin_amdgcn_global_load_lds((const unsigned*)(kr_ + offR[n]), (LAS unsigned*)(lds + A_KR + bs_ * 8192 + (aw + 4 * n) * 1024), 16, 0, 0); } while (0)
    float m_reg = -1e30f, l_reg = 0.f; f32x16 o[4]; bf16x8 qr[12];
#pragma unroll
    for (int d = 0; d < 4; ++d)
#pragma unroll
        for (int r = 0; r < 16; ++r) o[d][r] = 0.f;
#pragma unroll
    for (int d0 = 0; d0 < 12; ++d0)
#pragma unroll
        for (int i = 0; i < 8; ++i) qr[d0][i] = 0;
    if (Tatt > 0) CO_DMA(0);
    CO_BAR();
#pragma unroll 1
    for (int k = 0; k < T; ++k) {
        if (k < Tatt) {
            const int ui = k < 288 ? k / 36 : 8, j = k < 288 ? k % 36 : k - 288; const AUnit u = a_unit(ui, bid); const int ntu = u.nk / KVBLK;
            const size_t r0 = (size_t)u.b * LT + u.qrow + aw * QBLK;
            if (k + 1 < Tatt) CO_DMA(k + 1);
            if (j == 0) {
                const bf16_t* Qw = Q + (r0 + r32) * 1536 + u.h * 192 + hi * 8;
#pragma unroll
                for (int d0 = 0; d0 < 8; ++d0) qr[d0] = *(const bf16x8*)(Qw + d0 * 16);
#pragma unroll
                for (int d0 = 8; d0 < 12; ++d0) { bf16x8 x = *(const bf16x8*)(Qw + 128 + (d0 - 8) * 16);
                    if (u.rope >= 0) { const int pos = u.rope + aw * QBLK + r32, pi = (d0 - 8) * 8 + hi * 4;
                        const f32x4 c = *(const f32x4*)(COS + pos * 32 + pi), s = *(const f32x4*)(SIN + pos * 32 + pi);
                        float f[8]; unpack8(x, f); float g[8];
#pragma unroll
                        for (int i = 0; i < 4; ++i) { g[2 * i] = f[2 * i] * c[i] - f[2 * i + 1] * s[i]; g[2 * i + 1] = f[2 * i] * s[i] + f[2 * i + 1] * c[i]; }
                        x = pack8(g); }
                    qr[d0] = x; }
                m_reg = -1e30f; l_reg = 0.f;
#pragma unroll
                for (int d = 0; d < 4; ++d)
#pragma unroll
                    for (int r = 0; r < 16; ++r) o[d][r] = 0.f;
            }
            const int bsel = k & 1;
            f32x16 p0, p1;
#pragma unroll
            for (int r = 0; r < 16; ++r) { p0[r] = 0.f; p1[r] = 0.f; }
            { const LAS char* Kn_l = lds + A_KN + bsel * 16384; const LAS char* Kr_l = lds + A_KR + bsel * 8192;
#pragma unroll
              for (int d0 = 0; d0 < 8; ++d0) { const int cb = (d0 * 16 + hi * 8) * 2;
                const bf16x8 b0 = *(const LAS bf16x8*)(Kn_l + (r32 * 256 + (cb ^ ((r32 & 7) << 4)))), b1 = *(const LAS bf16x8*)(Kn_l + ((32 + r32) * 256 + (cb ^ ((r32 & 7) << 4))));
                p0 = __builtin_amdgcn_mfma_f32_32x32x16_bf16(b0, qr[d0], p0, 0, 0, 0); p1 = __builtin_amdgcn_mfma_f32_32x32x16_bf16(b1, qr[d0], p1, 0, 0, 0); }
#pragma unroll
              for (int d0 = 8; d0 < 12; ++d0) { const int ch = ((d0 - 8) * 2 + hi) ^ krsw;
                const bf16x8 b0 = *(const LAS bf16x8*)(Kr_l + r32 * 128 + ch * 16), b1 = *(const LAS bf16x8*)(Kr_l + (32 + r32) * 128 + ch * 16);
                p0 = __builtin_amdgcn_mfma_f32_32x32x16_bf16(b0, qr[d0], p0, 0, 0, 0); p1 = __builtin_amdgcn_mfma_f32_32x32x16_bf16(b1, qr[d0], p1, 0, 0, 0); } }
            float mn, alpha; partialSM(p0, p1, m_reg, mn, alpha);
            if (__any(alpha < 1.f)) { if (hi == 0) al_l[r32] = alpha; asm volatile("s_waitcnt lgkmcnt(0)" ::: "memory");
#pragma unroll
                for (int d = 0; d < 4; ++d)
#pragma unroll
                    for (int r = 0; r < 16; ++r) o[d][r] *= al_l[crow(r, hi)]; }
            bf16x8 pa0, pa1, pa2, pa3; finishSM(p0, p1, alpha, l_reg, pa0, pa1, pa2, pa3); __builtin_amdgcn_sched_barrier(0);
            { const int vb = vb0 + bsel * 16384;
              pv_one<0>(o[0], vb, pa0, pa1, pa2, pa3); pv_one<1>(o[1], vb, pa0, pa1, pa2, pa3); pv_one<2>(o[2], vb, pa0, pa1, pa2, pa3); pv_one<3>(o[3], vb, pa0, pa1, pa2, pa3); }
            if (j == ntu - 1) {
                if (hi == 0) li_l[r32] = l_reg; asm volatile("s_waitcnt lgkmcnt(0)" ::: "memory");
                bf16_t* Ow = MIX + r0 * 2048 + 512 + u.h * 128;
#pragma unroll
                for (int r = 0; r < 16; ++r) { const int orow = crow(r, hi); const float rl = __builtin_amdgcn_rcpf(li_l[orow]);
#pragma unroll
                    for (int d0 = 0; d0 < 4; ++d0) Ow[(size_t)orow * 2048 + d0 * 32 + r32] = f2bf(o[d0][r] * rl); }
            }
        }
        CO_BAR();
    }
#undef CO_DMA
}
#undef CO_BAR
#undef CO_BAR_S
}

template <int MODE>
__device__ __forceinline__ void corun_phase(const Params& p, LAS unsigned char* lds, int l, int bid) {
    const int Tatt = 288 + ((l < DEPTH - 1) ? 4 : 0), T = Tatt > co::NTS + 2 ? Tatt : co::NTS + 2;
    __syncthreads();
    if (__builtin_amdgcn_readfirstlane(tid_() >> 6) < 4) { if (MODE == 1 || MODE == 3) co::scan_role<(MODE == 3), 1>(p, lds, bid, T); else if (MODE != 2) co::scan_role<0, 0>(p, lds, bid, T); else { for (int k = 0; k <= T; ++k) __builtin_amdgcn_s_barrier(); } }
    else { if (MODE == 1 || MODE == 3) co::scan_role<(MODE == 3), 2>(p, lds, bid, T); else co::attn_role(p, lds, bid, Tatt, T); }
    __syncthreads();
}
struct DenseSched {
    const bf16_t* A; const bf16_t* Bt; int lda, K, nM, nN, G, c, skipctx;
    __device__ __forceinline__ bool next(int i, pg8::Unit& u) const {
        int pm, pn; if (!pg8::tile_order((long)i * G + c, nM, nN, pm, pn)) return false;
        if (skipctx) pm = (pm >> 3) * 9 + 1 + (pm & 7);
        u.a = (const char*)(A + (size_t)pm * 256 * lda); u.b = (const char*)(Bt + (size_t)pn * 256 * K); u.row0 = pm * 256; u.col0 = pn * 256; u.lst = nullptr; u.aux = 0; return true;
    }
};
struct MoeSched {
    const bf16_t* A; const bf16_t* Bt; size_t bstride; int lda, K, npn; const LAS int* toff; const int* list; int G, c, gather;
    __device__ __forceinline__ bool next(int i, pg8::Unit& u) const {
        const int cx = ((G & 7) == 0) ? (c & 7) * (G >> 3) + (c >> 3) : c;
        const int L = i * G + cx, T = toff[16]; if (L >= T * npn) return false;
        const int rt = L / npn, pn = L % npn; int e = 0;
#pragma unroll
        for (int j = 1; j < 16; ++j) e += (rt >= toff[j]) ? 1 : 0;
        const int mt = rt - toff[e];
        u.b = (const char*)(Bt + (size_t)e * bstride + (size_t)pn * 256 * K);
        if (gather) { u.a = (const char*)A; u.lst = list + (size_t)e * MT + mt * 256; } else { u.a = (const char*)(A + (size_t)rt * 256 * lda); u.lst = nullptr; }
        u.row0 = rt * 256; u.col0 = pn * 256; u.aux = e; return true;
    }
};

constexpr int NPH_LAYER = 10, NPH = 2 + DEPTH * NPH_LAYER;
#ifndef PH_MASK
#define PH_MASK 0xFFFFF
#endif
#define PH(k) ((PH_MASK >> (k)) & 1)
#ifndef REP_MASK
#define REP_MASK 0
#endif
#define REPS(k) (1 + ((REP_MASK >> (k)) & 1))
#ifndef CORUN_PROBE
#define CORUN_PROBE 0
#endif
#ifndef PREP_PROBE
#define PREP_PROBE 0
#endif
#ifndef SCAN_PROBE
#define SCAN_PROBE 0
#endif

#ifdef DET_CHECK
#ifndef DET_BITS
#define DET_BITS 3
#endif
__device__ __forceinline__ void det_hash(const Params& p, LAS unsigned char* lds, int l, int bid, unsigned& hy, unsigned& hm) {
    const int tid = tid_();
    LAS unsigned* acc = (LAS unsigned*)(lds + LDS_MISC + 8192);
    __builtin_amdgcn_fence(__ATOMIC_RELEASE, "agent"); __syncthreads(); __builtin_amdgcn_fence(__ATOMIC_ACQUIRE, "agent");
    if (tid < 2) acc[tid] = 0u;
    __syncthreads();
    unsigned a = 0, c = 0;
    { const int dir = bid & 1, h = (bid >> 1) & 7, b = bid >> 4; const bf16_t* Yo = (const bf16_t*)(p.ws + (dir ? WS_YB : WS_YF));
      for (int i = tid; i < LT * 8; i += NTHR) { const int t = i >> 3, cc = (i & 7) * 8; const u32x4 v = *(const u32x4*)(Yo + ((size_t)b * LT + t) * 512 + h * 64 + cc);
          a += (v[0] + 3u * v[1] + 5u * v[2] + 7u * v[3]) * (2u * (unsigned)i + 1u); } }
    { const bf16_t* MIX = (const bf16_t*)(p.ws + WS_MIX); const int nu = 8 + (l < DEPTH - 1 ? 1 : 0);
      for (int ui = 0; ui < nu; ++ui) { const co::AUnit u = co::a_unit(ui, bid);
          for (int i = tid; i < 128 * 16; i += NTHR) { const int r = i >> 4, cc = (i & 15) * 8; const u32x4 v = *(const u32x4*)(MIX + ((size_t)u.b * LT + u.qrow + r) * 2048 + 512 + u.h * 128 + cc);
              c += (v[0] + 3u * v[1] + 5u * v[2] + 7u * v[3]) * (2u * (unsigned)(ui * 2048 + i) + 1u); } } }
    __hip_atomic_fetch_add(acc, a, __ATOMIC_RELAXED, __HIP_MEMORY_SCOPE_WORKGROUP); __hip_atomic_fetch_add(acc + 1, c, __ATOMIC_RELAXED, __HIP_MEMORY_SCOPE_WORKGROUP);
    __syncthreads();
    hy = acc[0]; hm = acc[1];
    __syncthreads();
}
#endif
__global__ void __launch_bounds__(NTHR, 2) mega_fwd(Params p) {
    extern __shared__ __attribute__((aligned(16))) unsigned char shm[];
    LAS unsigned char* lds = (LAS unsigned char*)shm;
    const int tid = threadIdx.x, bid = blockIdx.x, G = gridDim.x;
    if (tid < 64) ((LAS unsigned*)(lds + LDS_MISC))[tid] = 0u;
    __syncthreads();
    XcdBarrier bar = xcd_barrier_post((unsigned*)(p.ws + WS_CTL) + CW_BAR, (volatile LAS unsigned*)(lds + LDS_MISC));
    const int lo = p.ph_lo, hi = p.ph_hi;
#define IN(k) (lo <= (k) && (k) < hi)
#ifndef DBL_BAR
#define DBL_BAR 0
#endif
#define YOUNG_ON() do { if (__builtin_amdgcn_readfirstlane((int)threadIdx.x) >= 256) __builtin_amdgcn_s_setprio(1); } while (0)
#define YOUNG_OFF() __builtin_amdgcn_s_setprio(0)
#define SEAM(k) do { if (IN(k) && IN((k) + 1)) { xcd_barrier(bar); if (DBL_BAR) xcd_barrier(bar); } } while (0)
    if (IN(0)) { if (PH(0)) { mod_phase(p, lds, bid, G); rope_tables(p, bid, G); } if (PH(15)) { _Pragma("unroll") for (int rp = 0; rp < REPS(15); ++rp) convert_weights(p, lds, 0, bid, G); } }
    SEAM(0);
    if (IN(1)) { if (PH(1)) modulate_phase(p, 0, bid, G); }
    SEAM(1);
    const Params& p0 = p; const int bid0 = bid, G0 = G;
    for (int l = 0; l < DEPTH; ++l) {
        const int pb = 2 + l * NPH_LAYER;
        Params p = p0; int bid = bid0, G = G0;
        { unsigned char* w_ = p.ws; float* o_ = p.out; asm volatile("" : "+s"(w_), "+s"(o_), "+s"(bid), "+s"(G)); p.ws = w_; p.out = o_; }
        if (IN(pb + 0) && PH(2)) {
            DenseSched S{(const bf16_t*)(p.ws + WS_ACT), (const bf16_t*)(p.ws + WS_WIN), DM, DM, MT / 256, NPC / 256, G, bid, 0};
            pg8::EpiBf16<0> E{(bf16_t*)(p.ws + WS_P), NPC, nullptr};
            _Pragma("unroll") for (int rp = 0; rp < REPS(2); ++rp) pg8::gemm_phase<pg8::EpiBf16<0>, DenseSched, false>(lds, DM, DM, S, E, 0);
        }
        SEAM(pb + 0);
        if (IN(pb + 1)) { if (PH(3)) { YOUNG_ON(); prep_phase<0>(p, lds, l, bid, G); YOUNG_OFF(); if (REPS(3) > 1) prep_phase<PREP_PROBE>(p, lds, l, bid, G); } }
        SEAM(pb + 1);
#ifndef USE_CORUN
#define USE_CORUN 1
#endif
        const bool corun = USE_CORUN && (G == 256);
        if (IN(pb + 2)) {
            if (PH(5)) { _Pragma("unroll") for (int rp = 0; rp < REPS(5); ++rp) ret_phase(p, lds, bid, G); }
            if (PH(6)) {
                DenseSched S{(const bf16_t*)(p.ws + WS_P) + PC_CQ, (const bf16_t*)(p.ws + WS_WUQ), NPC, 512, MT / 256, 1536 / 256, G, bid, 0};
                pg8::EpiBf16<0> E{(bf16_t*)(p.ws + WS_Q), 1536, (const float*)(p.ws + WS_RSQ)};
                _Pragma("unroll") for (int rp = 0; rp < REPS(6); ++rp) pg8::gemm_phase<pg8::EpiBf16<0>, DenseSched, false>(lds, 512, NPC, S, E, 0);
            }
            if (PH(7)) {
                DenseSched S{(const bf16_t*)(p.ws + WS_P) + PC_CKV, (const bf16_t*)(p.ws + WS_WUKV), NPC, 256, MT / 256, 2048 / 256, G, bid, 0};
                pg8::EpiBf16<0> E{(bf16_t*)(p.ws + WS_KV), 2048, (const float*)(p.ws + WS_RSKV)};
                _Pragma("unroll") for (int rp = 0; rp < REPS(7); ++rp) pg8::gemm_phase<pg8::EpiBf16<0>, DenseSched, false>(lds, 256, NPC, S, E, 0);
            }
        }
        SEAM(pb + 2);
#ifndef SEQ_SCAN
#define SEQ_SCAN 1
#endif
#ifdef DET_CHECK
        if (IN(pb + 3)) { unsigned hy0 = 0, hm0 = 0;
            for (int rp = 0; rp < DET_CHECK; ++rp) { corun_phase<0>(p, lds, l, bid); unsigned hy, hm; det_hash(p, lds, l, bid, hy, hm);
                if (rp == 0) { hy0 = hy; hm0 = hm; } else if (threadIdx.x == 0) { const unsigned bad = ((hy != hy0 ? 1u : 0u) | (hm != hm0 ? 2u : 0u)) & DET_BITS; if (bad) atomicOr((unsigned*)(p.ws + WS_CTL) + CW_DET, bad); } } }
#else
        if (IN(pb + 3)) { if (corun) { if (PH(8)) { if (SEQ_SCAN) { corun_phase<1>(p, lds, l, bid); attn_phase(p, lds, l, bid, G); } else corun_phase<0>(p, lds, l, bid); if (REPS(8) > 1) corun_phase<CORUN_PROBE>(p, lds, l, bid); } } else if (PH(8)) attn_phase(p, lds, l, bid, G); }
#endif
        SEAM(pb + 3);
        if (IN(pb + 4)) { if (PH(9)) finish_phase(p, l, bid, G); }
        SEAM(pb + 4);
        if (IN(pb + 5) && PH(10)) {
            const int last = (l == DEPTH - 1);
            DenseSched S{(const bf16_t*)(p.ws + WS_MIX), (const bf16_t*)(p.ws + WS_WOUT), DM, DM, last ? NB * 8 : MT / 256, DM / 256, G, bid, last};
            pg8::EpiBf16<0> E{(bf16_t*)(p.ws + WS_MO), DM, nullptr};
            _Pragma("unroll") for (int rp = 0; rp < REPS(10); ++rp) pg8::gemm_phase<pg8::EpiBf16<0>, DenseSched, false>(lds, DM, DM, S, E, 0);
        }
        SEAM(pb + 5);
        if (IN(pb + 6)) { if (PH(11)) { YOUNG_ON(); ln1_phase<0>(p, lds, l, bid, G); YOUNG_OFF(); if (REPS(11) > 1) ln1_phase<1>(p, lds, l, bid, G); } }
        SEAM(pb + 6);
        if (IN(pb + 7) && PH(12)) {
            moe_prefix(p, lds, l);
            MoeSched S{(const bf16_t*)(p.ws + WS_ACT), (const bf16_t*)(p.ws + WS_W13), (size_t)1024 * DM, DM, DM, 4, (const LAS int*)(lds + LDS_MISC + 64), (const int*)(p.ws + WS_LIST), G, bid, 1};
            pg8::EpiBf16<1> E{(bf16_t*)(p.ws + WS_H), DEXP, nullptr};
            _Pragma("unroll") for (int rp = 0; rp < REPS(12); ++rp) pg8::gemm_phase<pg8::EpiBf16<1>, MoeSched, true>(lds, DM, DM, S, E, MT - 1);
        }
        SEAM(pb + 7);
        if (IN(pb + 8) && PH(13)) {
            moe_prefix(p, lds, l);
            MoeSched S{(const bf16_t*)(p.ws + WS_H), (const bf16_t*)(p.ws + WS_W2), (size_t)DM * DEXP, DEXP, DEXP, 8, (const LAS int*)(lds + LDS_MISC + 64), nullptr, G, bid, 0};
            pg8::EpiBf16<0> E{(bf16_t*)(p.ws + WS_Y), DM, nullptr};
            _Pragma("unroll") for (int rp = 0; rp < REPS(13); ++rp) pg8::gemm_phase<pg8::EpiBf16<0>, MoeSched, false>(lds, DEXP, DEXP, S, E, 0);
        }
        SEAM(pb + 8);
        if (IN(pb + 9)) { if (PH(14)) { YOUNG_ON(); ln2_phase<0>(p, lds, l, bid, G); YOUNG_OFF(); if (REPS(14) > 1) ln2_phase<1>(p, lds, l, bid, G); } if (PH(15) && l + 1 < DEPTH) { _Pragma("unroll") for (int rp = 0; rp < REPS(15); ++rp) convert_weights(p, lds, l + 1, bid, G); } }
        SEAM(pb + 9);
    }
#ifdef DET_CHECK
    { const unsigned f = __hip_atomic_load((unsigned*)(p.ws + WS_CTL) + CW_DET, __ATOMIC_RELAXED, __HIP_MEMORY_SCOPE_AGENT);
      if (f && threadIdx.x == 0) p.out[(size_t)bid * 4096 + (f & 3)] = __builtin_nanf(""); }
#endif
#undef IN
#undef SEAM
}

extern "C" void kernel_launch(void* const* d_in, const int* in_sizes, int n_in, void* d_out, int out_size, void* d_ws, size_t ws_size, hipStream_t stream) {
    static int grid = 0;
    if (grid == 0) {
        if (n_in != 34 || ws_size < WS_END) { fprintf(stderr, "kernel_launch: need 34 inputs and >= %zu bytes of workspace; got n_in %d, ws %zu; nothing launched\n", (size_t)WS_END, n_in, ws_size); grid = -1; return; }
        int dev = 0, cus = 0, per_cu = 0;
        if (hipGetDevice(&dev) != hipSuccess || hipDeviceGetAttribute(&cus, hipDeviceAttributeMultiprocessorCount, dev) != hipSuccess) { fprintf(stderr, "kernel_launch: device query failed\n"); grid = -1; return; }
        if (hipFuncSetAttribute((const void*)mega_fwd, hipFuncAttributeMaxDynamicSharedMemorySize, LDS_BYTES) != hipSuccess) { fprintf(stderr, "kernel_launch: hipFuncSetAttribute failed\n"); grid = -1; return; }
        if (hipOccupancyMaxActiveBlocksPerMultiprocessor(&per_cu, (const void*)mega_fwd, NTHR, LDS_BYTES) != hipSuccess || per_cu < 1)
            fprintf(stderr, "kernel_launch: note: occupancy query reports %d workgroups per CU\n", per_cu);
        (void)hipGetLastError();
        grid = cus;
        if (grid != 256) fprintf(stderr, "kernel_launch: this kernel is built for 256 CUs (one RWKV scan per workgroup); found %d\n", cus);
    }
    if (grid < 0) return;
    if (hipMemsetAsync((char*)d_ws + WS_CTL, 0, CTL_BYTES, stream) != hipSuccess) { fprintf(stderr, "kernel_launch: memset failed\n"); return; }
    Params p;
    memset(&p, 0, sizeof(p));
    for (int i = 0; i < 34; ++i) p.in[i] = (const float*)d_in[i];
    p.out = (float*)d_out; p.ws = (unsigned char*)d_ws;
#ifndef MK_PER_PHASE
    p.ph_lo = 0; p.ph_hi = NPH;
#ifdef DBG_PHI
    p.ph_hi = DBG_PHI;
#endif
    hipLaunchKernelGGL(mega_fwd, dim3(grid), dim3(NTHR), LDS_BYTES, stream, p);
#else
    for (int k = 0; k < NPH; ++k) { p.ph_lo = k; p.ph_hi = k + 1; hipLaunchKernelGGL(mega_fwd, dim3(grid), dim3(NTHR), LDS_BYTES, stream, p); }
#endif
    const hipError_t le = hipPeekAtLastError();
    if (le != hipSuccess) fprintf(stderr, "kernel_launch: launch failed: %s\n", hipGetErrorName(le));
}
```
